# Optimizing an MI355X kernel written in HIP

```python
import jax, jax.numpy as jnp
from jax import lax
import numpy as np

D_MODEL = 1024
BATCH = 8
SEQ = 2048
DEPTH = 1
DEC_BATCH = 128
DEC_SEQ = 4
PAST_LEN = 16384
PAGE_SIZE = 128

N_META = 16
MIX_W = D_MODEL
POOL_W = MIX_W // 2
CONV_W = MIX_W - POOL_W
POOL_WINDOWS = (2, 4, 8, 16)
N_POOL_GROUPS = len(POOL_WINDOWS)
POOL_GC = POOL_W // N_POOL_GROUPS
POOL_BUF = max(POOL_WINDOWS) - 1
CONV_K = 3
D_FF = 2816
EPS = 1e-6

kernel_name = "hybrid_pool_shortconv_convffn_step"


def _rmsnorm(x, g):
    xf = x.astype(jnp.float32)
    y = xf * lax.rsqrt(jnp.mean(xf * xf, axis=-1, keepdims=True) + EPS)
    return (y * g.astype(jnp.float32)).astype(x.dtype)


def _causal_dwconv(z, prev, w):
    T = z.shape[1]
    ext = jnp.concatenate([prev.astype(z.dtype), z], axis=1)
    y = ext[:, 0:T] * w[0]
    for k in range(1, CONV_K):
        y = y + ext[:, k:k + T] * w[k]
    return y, ext[:, -(CONV_K - 1):]


def _multi_scale_pool(u, prev, start_pos):
    T = u.shape[1]
    ext = jnp.concatenate([prev.astype(u.dtype), u], axis=1)
    extf = ext.astype(jnp.float32)
    cs = jnp.concatenate([jnp.zeros_like(extf[:, :1]), jnp.cumsum(extf, axis=1)], axis=1)
    end = cs[:, POOL_BUF + 1:POOL_BUF + 1 + T]
    pos = start_pos + jnp.arange(T)
    outs = []
    for g, w in enumerate(POOL_WINDOWS):
        sl = slice(g * POOL_GC, (g + 1) * POOL_GC)
        begin = cs[:, POOL_BUF + 1 - w:POOL_BUF + 1 - w + T, sl]
        cnt = jnp.minimum(pos + 1, w).astype(jnp.float32)[None, :, None]
        outs.append((end[..., sl] - begin) / cnt)
    pooled = jnp.concatenate(outs, axis=-1) - u.astype(jnp.float32)
    return pooled.astype(u.dtype), ext[:, -POOL_BUF:]


def _layer(x, prev_pool, prev_conv, prev_ffn, start_pos,
           norm_mix, w_in, w_pool, pool_scale, conv_w, w_out,
           norm_ffn, w_up, ffn_conv_w, ffn_conv_b, w_down):
    Bn, T, _ = x.shape
    h = _rmsnorm(x, norm_mix)
    proj = h @ w_in
    u = proj[..., :POOL_W]
    gb = proj[..., POOL_W:POOL_W + CONV_W]
    gc = proj[..., POOL_W + CONV_W:POOL_W + 2 * CONV_W]
    v = proj[..., POOL_W + 2 * CONV_W:]
    d, new_pool = _multi_scale_pool(u, prev_pool, start_pos)
    d = d.reshape(Bn, T, N_POOL_GROUPS, POOL_GC)
    a = jnp.einsum('btgc,gcd->btgd', d, w_pool).reshape(Bn, T, POOL_W) * pool_scale
    conv, new_conv = _causal_dwconv(gc * v, prev_conv, conv_w)
    b = gb * conv
    x = x + jnp.concatenate([a, b], axis=-1) @ w_out
    h = _rmsnorm(x, norm_ffn)
    up = h @ w_up
    upc, new_ffn = _causal_dwconv(up, prev_ffn, ffn_conv_w)
    upc = upc + ffn_conv_b
    val, gate = upc[..., :D_FF], upc[..., D_FF:]
    x = x + (jax.nn.silu(gate) * val) @ w_down
    return x, new_pool, new_conv, new_ffn


def setup_inputs(seed: int = 0) -> dict:
    key = jax.random.key(seed)
    ks = jax.random.split(key, 20)
    n = jax.random.normal
    f32 = jnp.float32
    return {
        "x_prompt": n(ks[0], (BATCH, SEQ, D_MODEL), f32),
        "x_sample": n(ks[1], (DEC_BATCH, DEC_SEQ, D_MODEL), f32),
        "state_pool": n(ks[2], (DEPTH, DEC_BATCH, POOL_BUF, POOL_W), f32),
        "state_conv": n(ks[3], (DEPTH, DEC_BATCH, CONV_K - 1, CONV_W), f32),
        "state_ffn": n(ks[4], (DEPTH, DEC_BATCH, CONV_K - 1, 2 * D_FF), f32),
        "meta_tokens": n(ks[5], (N_META, D_MODEL), f32),
        "norm_mix": 1.0 + 0.05 * n(ks[6], (DEPTH, D_MODEL), f32),
        "w_in": n(ks[7], (DEPTH, D_MODEL, POOL_W + 3 * CONV_W), f32) * D_MODEL ** -0.5,
        "w_pool": n(ks[8], (DEPTH, N_POOL_GROUPS, POOL_GC, POOL_GC), f32) * POOL_GC ** -0.5,
        "pool_scale": 1.0 + 0.1 * n(ks[9], (DEPTH, POOL_W), f32),
        "conv_w": n(ks[10], (DEPTH, CONV_K, CONV_W), f32) * CONV_K ** -0.5,
        "w_out": n(ks[11], (DEPTH, MIX_W, D_MODEL), f32) * MIX_W ** -0.5,
        "norm_ffn": 1.0 + 0.05 * n(ks[12], (DEPTH, D_MODEL), f32),
        "w_up": n(ks[13], (DEPTH, D_MODEL, 2 * D_FF), f32) * D_MODEL ** -0.5,
        "ffn_conv_w": n(ks[14], (DEPTH, CONV_K, 2 * D_FF), f32) * CONV_K ** -0.5,
        "ffn_conv_b": 0.02 * n(ks[15], (DEPTH, 2 * D_FF), f32),
        "w_down": n(ks[16], (DEPTH, D_FF, D_MODEL), f32) * D_FF ** -0.5,
        "norm_final": 1.0 + 0.05 * n(ks[17], (D_MODEL,), f32),
    }


def reference(x_prompt, x_sample, state_pool, state_conv, state_ffn, meta_tokens,
              norm_mix, w_in, w_pool, pool_scale, conv_w, w_out,
              norm_ffn, w_up, ffn_conv_w, ffn_conv_b, w_down, norm_final):
    Bp = x_prompt.shape[0]
    meta = jnp.broadcast_to(meta_tokens.astype(x_prompt.dtype)[None], (Bp, N_META, D_MODEL))
    xp = jnp.concatenate([meta, x_prompt], axis=1)
    xs = x_sample
    zp_pool = jnp.zeros((Bp, POOL_BUF, POOL_W), xp.dtype)
    zp_conv = jnp.zeros((Bp, CONV_K - 1, CONV_W), xp.dtype)
    zp_ffn = jnp.zeros((Bp, CONV_K - 1, 2 * D_FF), xp.dtype)
    pp, pc, pf, sp, sc, sf = [], [], [], [], [], []
    for l in range(DEPTH):
        params = (norm_mix[l], w_in[l], w_pool[l], pool_scale[l], conv_w[l], w_out[l],
                  norm_ffn[l], w_up[l], ffn_conv_w[l], ffn_conv_b[l], w_down[l])
        xp, a1, a2, a3 = _layer(xp, zp_pool, zp_conv, zp_ffn, 0, *params)
        xs, b1, b2, b3 = _layer(xs, state_pool[l], state_conv[l], state_ffn[l], PAST_LEN, *params)
        pp.append(a1); pc.append(a2); pf.append(a3)
        sp.append(b1); sc.append(b2); sf.append(b3)
    y_prompt = _rmsnorm(xp[:, N_META:], norm_final)
    y_sample = _rmsnorm(xs, norm_final)
    return (y_prompt, y_sample,
            jnp.stack(pp), jnp.stack(pc), jnp.stack(pf),
            jnp.stack(sp), jnp.stack(sc), jnp.stack(sf))
```

```cpp
#include <hip/hip_runtime.h>
#include <stdint.h>

namespace {
constexpr int D = 1024, NB = 8, SEQ = 2048, NMETA = 16, PL = SEQ + NMETA, TP = NB * PL, DB = 128, DS = 4, TS = DB * DS, T = TP + TS;
constexpr int MPAD = 17152;
constexpr int POOLW = 512, CONVW = 512, NIN = 2048, DFF = 2816, NUP = 5632, PBUF = 15;
constexpr float EPS = 1e-6f;
constexpr size_t O_YP = 0, O_YS = (size_t)NB * SEQ * D, O_PP = O_YS + (size_t)TS * D, O_CP = O_PP + (size_t)NB * PBUF * POOLW,
                 O_FP = O_CP + (size_t)NB * 2 * CONVW, O_PS = O_FP + (size_t)NB * 2 * NUP, O_CS = O_PS + (size_t)DB * PBUF * POOLW,
                 O_FS = O_CS + (size_t)DB * 2 * CONVW, O_END = O_FS + (size_t)DB * 2 * NUP;
constexpr size_t MiB = 1u << 20;
constexpr size_t WS_R0 = 1 * MiB, WS_SSQ1 = WS_R0 + 128 * 1024, WS_SSQ2 = WS_SSQ1 + 128 * 1024;
constexpr size_t WS_WIN = 2 * MiB, WS_WOUT = 6 * MiB, WS_WUP = 8 * MiB, WS_WDOWN = 19 * MiB, WS_WPOOL = 25 * MiB;
constexpr size_t WS_MIX = 26 * MiB, WS_X1B = 60 * MiB, WS_XB = 94 * MiB, WS_PROJ = 128 * MiB, WS_ACT = 94 * MiB, WS_DBUF = 196 * MiB;
constexpr int X1B_PADROWS = 16;

typedef unsigned short bf16_t;
typedef unsigned u32x4 __attribute__((ext_vector_type(4)));
typedef float f32x4 __attribute__((ext_vector_type(4)));

__device__ __forceinline__ unsigned f2bf(float f) { unsigned u = __float_as_uint(f); return (u + 0x7fffu + ((u >> 16) & 1u)) >> 16; }
__device__ __forceinline__ float bf2f(unsigned b) { return __uint_as_float(b << 16); }
__device__ __forceinline__ unsigned pk2(float lo, float hi) { return f2bf(lo) | (f2bf(hi) << 16); }

struct Params {
    const float *x_prompt, *x_sample, *state_pool, *state_conv, *state_ffn, *meta, *norm_mix, *w_in, *w_pool, *pool_scale, *conv_w, *w_out,
        *norm_ffn, *w_up, *ffn_conv_w, *ffn_conv_b, *w_down, *norm_final;
    float* out; unsigned char* ws;
};

__device__ __forceinline__ const float* xrow_ptr(const Params& p, int t) {
    if (t < TP) { const int b = t / PL, q = t % PL; return q < NMETA ? p.meta + (size_t)q * D : p.x_prompt + ((size_t)b * SEQ + (q - NMETA)) * D; }
    return p.x_sample + (size_t)(t - TP) * D;
}
__device__ __forceinline__ float* yrow_ptr(const Params& p, int t) {
    if (t < TP) { const int b = t / PL, q = t % PL; return q < NMETA ? nullptr : p.out + O_YP + ((size_t)b * SEQ + (q - NMETA)) * D; }
    if (t < T) return p.out + O_YS + (size_t)(t - TP) * D;
    return nullptr;
}
__device__ __forceinline__ float wave_sum(float v) {
#pragma unroll
    for (int o = 1; o < 64; o <<= 1) v += __shfl_xor(v, o);
    return v;
}

__device__ __forceinline__ int wup_src_col(int n) { const int pn = n >> 8, w = n & 255, bj = w >> 7, c = w & 127; return bj * DFF + 128 * pn + c; }
__global__ void k_prep_w(Params p) {
    const size_t gid = (size_t)blockIdx.x * blockDim.x + threadIdx.x, gs = (size_t)gridDim.x * blockDim.x;
    bf16_t* win = (bf16_t*)(p.ws + WS_WIN); bf16_t* wout = (bf16_t*)(p.ws + WS_WOUT); bf16_t* wup = (bf16_t*)(p.ws + WS_WUP); bf16_t* wdown = (bf16_t*)(p.ws + WS_WDOWN); bf16_t* wpool = (bf16_t*)(p.ws + WS_WPOOL);
    for (size_t i = gid; i < (size_t)NIN * D; i += gs) { const int n = i / D, k = i % D; win[i] = (bf16_t)f2bf(p.norm_mix[k] * p.w_in[(size_t)k * NIN + n]); }
    for (size_t i = gid; i < (size_t)D * D; i += gs) { const int n = i / D, k = i % D; wout[i] = (bf16_t)f2bf(p.w_out[(size_t)k * D + n]); }
    for (size_t i = gid; i < (size_t)NUP * D; i += gs) { const int n = i / D, k = i % D; wup[i] = (bf16_t)f2bf(p.norm_ffn[k] * p.w_up[(size_t)k * NUP + wup_src_col(n)]); }
    for (size_t i = gid; i < (size_t)D * DFF; i += gs) { const int n = i / DFF, k = i % DFF; wdown[i] = (bf16_t)f2bf(p.w_down[(size_t)k * D + n]); }
    for (size_t i = gid; i < (size_t)4 * 128 * 128; i += gs) { const int g = i / 16384, d = (i / 128) % 128, c = i % 128; wpool[i] = (bf16_t)f2bf(p.w_pool[(size_t)g * 16384 + c * 128 + d]); }
    float* ssq1 = (float*)(p.ws + WS_SSQ1); float* ssq2 = (float*)(p.ws + WS_SSQ2);
    for (size_t i = gid; i < MPAD; i += gs) { ssq1[i] = 0.f; ssq2[i] = 0.f; }
    bf16_t* x1b = (bf16_t*)(p.ws + WS_X1B);
    for (size_t i = gid; i < (size_t)X1B_PADROWS * D; i += gs) x1b[i] = 0;
}
__global__ void k_prep_x(Params p) {
    const int lane = threadIdx.x & 63, gw = (blockIdx.x * blockDim.x + threadIdx.x) >> 6, ngw = (gridDim.x * blockDim.x) >> 6;
    bf16_t* xb = (bf16_t*)(p.ws + WS_XB); float* r0 = (float*)(p.ws + WS_R0);
    for (int t = gw; t < MPAD; t += ngw) {
        unsigned long long* o8 = (unsigned long long*)(xb + (size_t)t * D) + lane;
        if (t >= T) { for (int j = 0; j < 4; ++j) o8[64 * j] = 0ull; if (lane == 0) r0[t] = 0.f; continue; }
        const f32x4* xr = (const f32x4*)xrow_ptr(p, t) + lane;
        f32x4 v[4]; float s = 0.f;
#pragma unroll
        for (int j = 0; j < 4; ++j) { v[j] = xr[64 * j]; s += (v[j].x * v[j].x + v[j].y * v[j].y) + (v[j].z * v[j].z + v[j].w * v[j].w); }
        s = wave_sum(s);
        if (lane == 0) r0[t] = rsqrtf(s * (1.f / D) + EPS);
#pragma unroll
        for (int j = 0; j < 4; ++j) o8[64 * j] = (unsigned long long)pk2(v[j].x, v[j].y) | ((unsigned long long)pk2(v[j].z, v[j].w) << 32);
    }
}

__device__ __forceinline__ float dot_bf16(const bf16_t* a, const bf16_t* b, int K) {
    const u32x4* a4 = (const u32x4*)a; const u32x4* b4 = (const u32x4*)b; float s = 0.f;
    for (int k = 0; k < K / 8; ++k) { const u32x4 x = a4[k], y = b4[k];
#pragma unroll
        for (int j = 0; j < 4; ++j) { s += bf2f(x[j] & 0xffffu) * bf2f(y[j] & 0xffffu); s += bf2f(x[j] >> 16) * bf2f(y[j] >> 16); } }
    return s;
}
__global__ void k_gemm_in(Params p) {
    const int n = blockIdx.x * 64 + (threadIdx.x & 63), t = blockIdx.y * 4 + (threadIdx.x >> 6);
    const bf16_t* xb = (const bf16_t*)(p.ws + WS_XB); const bf16_t* w = (const bf16_t*)(p.ws + WS_WIN); const float* r0 = (const float*)(p.ws + WS_R0);
    bf16_t* proj = (bf16_t*)(p.ws + WS_PROJ);
    const float acc = dot_bf16(xb + (size_t)t * D, w + (size_t)n * D, D);
    proj[(size_t)t * NIN + n] = (bf16_t)f2bf(acc * r0[t]);
}
__device__ __forceinline__ void tok_info(int t, bool& sample, int& seq, int& pos) { if (t < TP) { sample = false; seq = t / PL; pos = t % PL; } else { sample = true; seq = (t - TP) / DS; pos = (t - TP) % DS; } }

__global__ void k_mixer_a(Params p) {
    const int c = threadIdx.x & 511, t = blockIdx.x;
    if (t >= T) return;
    const bf16_t* proj = (const bf16_t*)(p.ws + WS_PROJ); bf16_t* dbuf = (bf16_t*)(p.ws + WS_DBUF); bf16_t* mix = (bf16_t*)(p.ws + WS_MIX);
    bool sample; int seq, pos; tok_info(t, sample, seq, pos);
    const int g = c >> 7, w = 2 << g;
    float s = 0.f;
    for (int i = 0; i < w; ++i) {
        const int q = pos - i;
        float u;
        if (q >= 0) u = bf2f(proj[(size_t)(t - i) * NIN + c]);
        else u = sample ? p.state_pool[((size_t)seq * PBUF + (PBUF + q)) * POOLW + c] : 0.f;
        s += u;
    }
    const float cnt = sample ? (float)w : (float)min(pos + 1, w);
    const float ut = bf2f(proj[(size_t)t * NIN + c]);
    dbuf[(size_t)t * POOLW + c] = (bf16_t)f2bf(s / cnt - ut);
    if (!sample) { if (pos >= PL - PBUF) p.out[O_PP + ((size_t)seq * PBUF + (pos - (PL - PBUF))) * POOLW + c] = ut; }
    else { p.out[O_PS + ((size_t)seq * PBUF + (PBUF - DS + pos)) * POOLW + c] = ut;
           for (int r = pos; r < PBUF - DS; r += DS) p.out[O_PS + ((size_t)seq * PBUF + r) * POOLW + c] = p.state_pool[((size_t)seq * PBUF + r + DS) * POOLW + c]; }
    float z[3];
#pragma unroll
    for (int i = 0; i < 3; ++i) {
        const int q = pos - 2 + i;
        if (q >= 0) { const size_t r = (size_t)(t - 2 + i) * NIN; z[i] = bf2f(proj[r + 1024 + c]) * bf2f(proj[r + 1536 + c]); }
        else z[i] = sample ? p.state_conv[((size_t)seq * 2 + (2 + q)) * CONVW + c] : 0.f;
    }
    const float conv = p.conv_w[c] * z[0] + p.conv_w[CONVW + c] * z[1] + p.conv_w[2 * CONVW + c] * z[2];
    const float gb = bf2f(proj[(size_t)t * NIN + 512 + c]);
    mix[(size_t)t * D + 512 + c] = (bf16_t)f2bf(gb * conv);
    if (!sample) { if (pos >= PL - 2) p.out[O_CP + ((size_t)seq * 2 + (pos - (PL - 2))) * CONVW + c] = z[2]; }
    else { if (pos >= DS - 2) p.out[O_CS + ((size_t)seq * 2 + (pos - (DS - 2))) * CONVW + c] = z[2]; }
}
__global__ void k_mixer_b(Params p) {
    const int c = threadIdx.x & 511, t = blockIdx.x;
    const bf16_t* dbuf = (const bf16_t*)(p.ws + WS_DBUF); const bf16_t* wp = (const bf16_t*)(p.ws + WS_WPOOL); bf16_t* mix = (bf16_t*)(p.ws + WS_MIX);
    if (t >= T) { mix[(size_t)t * D + c] = 0; mix[(size_t)t * D + 512 + c] = 0; return; }
    const int g = c >> 7, d = c & 127;
    const float acc = dot_bf16(dbuf + (size_t)t * POOLW + g * 128, wp + ((size_t)g * 128 + d) * 128, 128);
    mix[(size_t)t * D + c] = (bf16_t)f2bf(acc * p.pool_scale[c]);
}
__global__ void k_gemm_out(Params p) {
    const int n = blockIdx.x * 64 + (threadIdx.x & 63), t = blockIdx.y * 4 + (threadIdx.x >> 6);
    const bf16_t* mix = (const bf16_t*)(p.ws + WS_MIX); const bf16_t* w = (const bf16_t*)(p.ws + WS_WOUT);
    bf16_t* x1b = (bf16_t*)(p.ws + WS_X1B) + (size_t)X1B_PADROWS * D; float* ssq1 = (float*)(p.ws + WS_SSQ1);
    float v = 0.f;
    if (t < T) { v = xrow_ptr(p, t)[n] + dot_bf16(mix + (size_t)t * D, w + (size_t)n * D, D); float* y = yrow_ptr(p, t); if (y) y[n] = v; }
    x1b[(size_t)t * D + n] = (bf16_t)f2bf(v);
    const float s = wave_sum(v * v);
    if ((threadIdx.x & 63) == 0 && t < T) atomicAdd(ssq1 + t, s);
}
__global__ void k_gemm_up(Params p) {
    const int j = blockIdx.x * 64 + (threadIdx.x & 63), t = blockIdx.y * 4 + (threadIdx.x >> 6);
    if (t >= T) return;
    const bf16_t* x1b = (const bf16_t*)(p.ws + WS_X1B) + (size_t)X1B_PADROWS * D; const bf16_t* w = (const bf16_t*)(p.ws + WS_WUP); const float* ssq1 = (const float*)(p.ws + WS_SSQ1);
    bf16_t* act = (bf16_t*)(p.ws + WS_ACT);
    bool sample; int seq, pos; tok_info(t, sample, seq, pos);
    const int pn = j >> 7, cc = j & 127, nv = pn * 256 + cc, ng = nv + 128;
    float uv[3], ug[3];
#pragma unroll
    for (int i = 0; i < 3; ++i) {
        const int q = pos - 2 + i;
        if (q >= 0) { const int tt = t - 2 + i; const float r1 = rsqrtf(ssq1[tt] * (1.f / D) + EPS);
            uv[i] = r1 * dot_bf16(x1b + (size_t)tt * D, w + (size_t)nv * D, D); ug[i] = r1 * dot_bf16(x1b + (size_t)tt * D, w + (size_t)ng * D, D); }
        else if (sample) { uv[i] = p.state_ffn[((size_t)seq * 2 + (2 + q)) * NUP + j]; ug[i] = p.state_ffn[((size_t)seq * 2 + (2 + q)) * NUP + DFF + j]; }
        else { uv[i] = 0.f; ug[i] = 0.f; }
    }
    const float* cw = p.ffn_conv_w; const float* cb = p.ffn_conv_b;
    const float val = cw[j] * uv[0] + cw[NUP + j] * uv[1] + cw[2 * NUP + j] * uv[2] + cb[j];
    const float gate = cw[DFF + j] * ug[0] + cw[NUP + DFF + j] * ug[1] + cw[2 * NUP + DFF + j] * ug[2] + cb[DFF + j];
    const float sg = gate / (1.f + __expf(-gate));
    act[(size_t)t * DFF + j] = (bf16_t)f2bf(sg * val);
    if (!sample) { if (pos >= PL - 2) { float* o = p.out + O_FP + ((size_t)seq * 2 + (pos - (PL - 2))) * NUP; o[j] = uv[2]; o[DFF + j] = ug[2]; } }
    else { if (pos >= DS - 2) { float* o = p.out + O_FS + ((size_t)seq * 2 + (pos - (DS - 2))) * NUP; o[j] = uv[2]; o[DFF + j] = ug[2]; } }
}
__global__ void k_gemm_down(Params p) {
    const int n = blockIdx.x * 64 + (threadIdx.x & 63), t = blockIdx.y * 4 + (threadIdx.x >> 6);
    if (t >= T) return;
    float* y = yrow_ptr(p, t); if (!y) return;
    const bf16_t* act = (const bf16_t*)(p.ws + WS_ACT); const bf16_t* w = (const bf16_t*)(p.ws + WS_WDOWN); float* ssq2 = (float*)(p.ws + WS_SSQ2);
    const float v = y[n] + dot_bf16(act + (size_t)t * DFF, w + (size_t)n * DFF, DFF);
    y[n] = v;
    const float s = wave_sum(v * v);
    if ((threadIdx.x & 63) == 0) atomicAdd(ssq2 + t, s);
}
__global__ void k_final(Params p) {
    const int n = threadIdx.x, t = blockIdx.x;
    float* y = yrow_ptr(p, t); if (!y) return;
    const float* ssq2 = (const float*)(p.ws + WS_SSQ2);
    const float r = rsqrtf(ssq2[t] * (1.f / D) + EPS);
    y[n] = y[n] * r * p.norm_final[n];
}
}

extern "C" void kernel_launch(void* const* d_in, const int* in_sizes, int n_in, void* d_out, int out_size, void* d_ws, size_t ws_size, hipStream_t stream) {
    Params p{};
    p.x_prompt = (const float*)d_in[0]; p.x_sample = (const float*)d_in[1]; p.state_pool = (const float*)d_in[2]; p.state_conv = (const float*)d_in[3]; p.state_ffn = (const float*)d_in[4];
    p.meta = (const float*)d_in[5]; p.norm_mix = (const float*)d_in[6]; p.w_in = (const float*)d_in[7]; p.w_pool = (const float*)d_in[8]; p.pool_scale = (const float*)d_in[9];
    p.conv_w = (const float*)d_in[10]; p.w_out = (const float*)d_in[11]; p.norm_ffn = (const float*)d_in[12]; p.w_up = (const float*)d_in[13]; p.ffn_conv_w = (const float*)d_in[14];
    p.ffn_conv_b = (const float*)d_in[15]; p.w_down = (const float*)d_in[16]; p.norm_final = (const float*)d_in[17];
    p.out = (float*)d_out; p.ws = (unsigned char*)d_ws;
    k_prep_w<<<2048, 256, 0, stream>>>(p);
    k_prep_x<<<2048, 256, 0, stream>>>(p);
    k_gemm_in<<<dim3(NIN / 64, MPAD / 4), 256, 0, stream>>>(p);
    k_mixer_a<<<MPAD, 512, 0, stream>>>(p);
    k_mixer_b<<<MPAD, 512, 0, stream>>>(p);
    k_gemm_out<<<dim3(D / 64, MPAD / 4), 256, 0, stream>>>(p);
    k_gemm_up<<<dim3(DFF / 64, MPAD / 4), 256, 0, stream>>>(p);
    k_gemm_down<<<dim3(D / 64, MPAD / 4), 256, 0, stream>>>(p);
    k_final<<<T, 1024, 0, stream>>>(p);
}
```

```cpp
#include <hip/hip_runtime.h>
#include <cstdio>
#include <cstdint>

namespace {
constexpr int D = 1024, NB = 8, SEQ = 2048, NMETA = 16, PL = SEQ + NMETA, TP = NB * PL, DB = 128, DS = 4, TS = DB * DS, T = TP + TS;
constexpr int MPAD = 17152;
constexpr int POOLW = 512, CONVW = 512, NIN = 2048, DFF = 2816, NUP = 5632, PBUF = 15;
constexpr float EPS = 1e-6f;
constexpr int NM = MPAD / 256;
constexpr int EBLK = 62, ETILE = 4 * EBLK;
constexpr int NME = (T + ETILE - 1) / ETILE;
constexpr size_t O_YP = 0, O_YS = (size_t)NB * SEQ * D, O_PP = O_YS + (size_t)TS * D, O_CP = O_PP + (size_t)NB * PBUF * POOLW,
                 O_FP = O_CP + (size_t)NB * 2 * CONVW, O_PS = O_FP + (size_t)NB * 2 * NUP, O_CS = O_PS + (size_t)DB * PBUF * POOLW,
                 O_FS = O_CS + (size_t)DB * 2 * CONVW;
constexpr size_t MiB = 1u << 20;
constexpr size_t WS_CTL = 0, CTL_ZERO_BYTES = 64 * 1024;
constexpr size_t WS_R0 = 256 * 1024;
constexpr size_t WS_SSQ1 = 2 * MiB, WS_SSQ2 = 4 * MiB;
constexpr size_t WS_WIN = 6 * MiB, WS_WOUT = 10 * MiB, WS_WUP = 12 * MiB, WS_WDOWN = 23 * MiB, WS_WPOOL = 29 * MiB;
constexpr size_t WS_MIX = 30 * MiB, WS_X1B = 64 * MiB, WS_XB = 98 * MiB, WS_PROJ = 132 * MiB, WS_ACT = 98 * MiB, WS_END = 200 * MiB;
constexpr int X1B_PADROWS = 16;
static_assert(WS_MIX + (size_t)MPAD * D * 2 <= WS_X1B && WS_X1B + (size_t)(MPAD + X1B_PADROWS) * D * 2 <= WS_XB && WS_XB + (size_t)MPAD * D * 2 <= WS_PROJ &&
              WS_PROJ + (size_t)MPAD * NIN * 2 <= WS_END && WS_ACT + (size_t)MPAD * DFF * 2 <= WS_END && WS_WUP + (size_t)NUP * D * 2 <= WS_WDOWN && WS_WDOWN + (size_t)D * DFF * 2 <= WS_WPOOL, "d_ws map");
constexpr int CW_BAR = 1024;

struct Params {
    const float *x_prompt, *x_sample, *state_pool, *state_conv, *state_ffn, *meta, *norm_mix, *w_in, *w_pool, *pool_scale, *conv_w, *w_out,
        *norm_ffn, *w_up, *ffn_conv_w, *ffn_conv_b, *w_down, *norm_final;
    float* out; unsigned char* ws;
};
}

namespace pg8 {
#define PG8_LAS __attribute__((address_space(3)))
typedef unsigned short bf16_t;
typedef short bf16x8 __attribute__((ext_vector_type(8)));
typedef float f32x4 __attribute__((ext_vector_type(4)));
typedef unsigned u32x4 __attribute__((ext_vector_type(4)));
typedef unsigned u32x2 __attribute__((ext_vector_type(2)));
constexpr int BM = 256, BK = 64, HALF = 128, HTB = HALF * BK * 2  , STAGE_BYTES = 8 * HTB, NXCD = 8, WGM = 8;

__host__ __device__ __forceinline__ int lds_byte(int r, int c) { const int st = (r >> 4) * 2 + (c >> 5), rr = r & 15, cc = c & 31, ob = rr * 64 + cc * 2; return st * 1024 + (ob ^ (((ob >> 9) & 1) << 5)); }
__host__ __device__ __forceinline__ void stage_rc(int b, int& R, int& C) { const int st = b / 1024, sb = b % 1024, swz = sb ^ (((sb >> 9) & 1) << 5); R = (st >> 1) * 16 + swz / 64; C = (st & 1) * 32 + (swz % 64) / 2; }
__host__ __device__ __forceinline__ int perm32(int rho) { const int n = rho >> 4, i = rho & 15; return 8 * (i >> 2) + 4 * n + (i & 3); }

struct Unit { int pm, pn; };
struct Gemm { const bf16_t* A; const bf16_t* Bt; int K; int ablk; };

struct StaticOrder {
    int nM, nN, nwg, G, c;
    __host__ __device__ void init(int nM_, int nN_, int G_, int c_) { nM = nM_; nN = nN_; nwg = nM * nN; G = G_; c = c_; }
    __host__ __device__ bool next(int i, Unit& u) const {
        const long L = (long)i * G + c; if (L >= nwg) return false;
        int wgid = (int)L; { const int q = nwg / NXCD, r = nwg % NXCD, xcd = wgid % NXCD, off = wgid / NXCD; wgid = (xcd < r ? xcd * (q + 1) : r * (q + 1) + (xcd - r) * q) + off; }
        const int nig = WGM * nN, gid = wgid / nig, fm = gid * WGM, gsz = (nM - fm) < WGM ? (nM - fm) : WGM;
        u.pm = fm + ((wgid % nig) % gsz); u.pn = (wgid % nig) / gsz; return true;
    }
};

__device__ __forceinline__ unsigned cvt_pk_bf16(float lo, float hi) { unsigned r; asm volatile("v_cvt_pk_bf16_f32 %0, %1, %2" : "=v"(r) : "v"(lo), "v"(hi)); return r; }

template <class Epi, bool ALIGN_EPI>
__device__ __forceinline__ void gemm_phase(PG8_LAS unsigned char* lds, const Gemm g, const StaticOrder& S, const Epi& E) {
    const int tid = threadIdx.x, wid = __builtin_amdgcn_readfirstlane(tid >> 6), lane = tid & 63, wr = wid >> 2, wc = wid & 3, fr = lane & 15, fq = lane >> 4;
    const int K = g.K, nt = K / BK;
    unsigned voffA[2], voffB[2];
#pragma unroll
    for (int i = 0; i < 2; ++i) { int R, C; stage_rc(tid * 16 + i * 8192, R, C); const int Rb = Epi::PERM ? ((R & ~31) + perm32(R & 31)) : R; const int Ra = (R >> 6) * g.ablk + (R & 63);
        voffA[i] = (unsigned)(Ra * K + C) * 2u; voffB[i] = (unsigned)(Rb * K + C) * 2u; }
    const size_t kstep = (size_t)(BK * 2);
    const size_t hstepB = (size_t)HALF * K * 2, tstepB = 2 * hstepB;
    const size_t hstepA = (size_t)2 * g.ablk * K * 2, tstepA = 2 * hstepA;
    const unsigned ldsw = (unsigned)wid * 1024u;
    const int aoff = lds_byte(wr * 64 + fr, fq * 8), boff = lds_byte(wc * 32 + fr, fq * 8);
#define PG8_SA(b, h) (((b) * 2 + (h)) * HTB)
#define PG8_SB(b, h) ((4 + (b) * 2 + (h)) * HTB)
#define PG8_STAGE(bufoff, gbase, voff) do { _Pragma("unroll") for (int _i = 0; _i < 2; ++_i) \
        __builtin_amdgcn_global_load_lds((const unsigned*)((const char*)(gbase) + (voff)[_i]), (PG8_LAS unsigned*)(lds + (bufoff) + ldsw + _i * 8192), 16, 0, 0); } while (0)
#define PG8_LDA(dst, b, h) do { _Pragma("unroll") for (int m = 0; m < 4; ++m) _Pragma("unroll") for (int k = 0; k < 2; ++k) dst[m][k] = *(const PG8_LAS bf16x8*)(lds + PG8_SA(b, h) + aoff + m * 2048 + k * 1024); } while (0)
#define PG8_LDB(dst, b, h) do { _Pragma("unroll") for (int n = 0; n < 2; ++n) _Pragma("unroll") for (int k = 0; k < 2; ++k) dst[n][k] = *(const PG8_LAS bf16x8*)(lds + PG8_SB(b, h) + boff + n * 2048 + k * 1024); } while (0)
#define PG8_MMA(ai, bj, At, Bt) do { __builtin_amdgcn_s_setprio(1); _Pragma("unroll") for (int m = 0; m < 4; ++m) _Pragma("unroll") for (int n = 0; n < 2; ++n) _Pragma("unroll") for (int k = 0; k < 2; ++k) \
        acc[ai][bj][m][n] = __builtin_amdgcn_mfma_f32_16x16x32_bf16(Bt[n][k], At[m][k], acc[ai][bj][m][n], 0, 0, 0); __builtin_amdgcn_s_setprio(0); } while (0)
#define PG8_WAIT_V(n) asm volatile("s_waitcnt vmcnt(" #n ")" ::: "memory")
#define PG8_WAIT_L(n) asm volatile("s_waitcnt lgkmcnt(" #n ")" ::: "memory")
#define PG8_BAR __builtin_amdgcn_s_barrier()
#define PG8_SCHED __builtin_amdgcn_sched_barrier(0)
    Unit cur, nxt; int ui = 0;
    if (!S.next(0, cur)) return;
    f32x4 acc[2][2][4][2];
#pragma unroll
    for (int a = 0; a < 2; ++a)
#pragma unroll
        for (int b = 0; b < 2; ++b)
#pragma unroll
            for (int m = 0; m < 4; ++m)
#pragma unroll
                for (int n = 0; n < 2; ++n) acc[a][b][m][n] = (f32x4){0.f, 0.f, 0.f, 0.f};
    bf16x8 At[4][2], B0[2][2], B1[2][2];
    const char* cA = (const char*)g.A + (size_t)cur.pm * tstepA; const char* cB = (const char*)g.Bt + (size_t)cur.pn * tstepB;
    PG8_STAGE(PG8_SB(0, 0), cB, voffB); PG8_STAGE(PG8_SB(0, 1), cB + hstepB, voffB); PG8_STAGE(PG8_SA(0, 0), cA, voffA); PG8_STAGE(PG8_SA(0, 1), cA + hstepA, voffA);
    if (wr == 1) PG8_BAR;
    PG8_WAIT_V(2); PG8_BAR;
    PG8_STAGE(PG8_SB(1, 0), cB + kstep, voffB); PG8_STAGE(PG8_SA(1, 0), cA + kstep, voffA); PG8_STAGE(PG8_SB(1, 1), cB + hstepB + kstep, voffB);
    PG8_WAIT_V(6); PG8_BAR;
    for (;;) {
        const bool has_next = S.next(ui + 1, nxt);
        const char* nA = has_next ? (const char*)g.A + (size_t)nxt.pm * tstepA : cA; const char* nB = has_next ? (const char*)g.Bt + (size_t)nxt.pn * tstepB : cB;
        for (int t = 0; t < nt; t += 2) {
            const bool last = (t == nt - 2);
            const char* a1 = cA + (size_t)(t + 1) * kstep;
            const char* a2 = last ? nA : cA + (size_t)(t + 2) * kstep; const char* b2 = last ? nB : cB + (size_t)(t + 2) * kstep;
            const char* a3 = a2 + kstep; const char* b3 = b2 + kstep;
            PG8_LDB(B0, 0, 0); PG8_LDB(B1, 0, 1); PG8_SCHED; PG8_LDA(At, 0, 0); PG8_STAGE(PG8_SA(1, 1), a1 + hstepA, voffA);
            PG8_WAIT_V(8); PG8_WAIT_L(0); PG8_BAR; PG8_MMA(0, 0, At, B0); PG8_MMA(0, 1, At, B1); PG8_BAR; PG8_SCHED;
            PG8_LDA(At, 0, 1); PG8_STAGE(PG8_SB(0, 0), b2, voffB); PG8_STAGE(PG8_SB(0, 1), b2 + hstepB, voffB); PG8_STAGE(PG8_SA(0, 0), a2, voffA);
            PG8_WAIT_V(8); PG8_WAIT_L(0); PG8_BAR; PG8_MMA(1, 0, At, B0); PG8_MMA(1, 1, At, B1); PG8_BAR; PG8_SCHED;
            PG8_LDB(B0, 1, 0); PG8_LDB(B1, 1, 1); PG8_SCHED; PG8_LDA(At, 1, 0); PG8_STAGE(PG8_SA(0, 1), a2 + hstepA, voffA);
            PG8_WAIT_V(8); PG8_WAIT_L(0); PG8_BAR; PG8_MMA(0, 0, At, B0); PG8_MMA(0, 1, At, B1); PG8_BAR; PG8_SCHED;
            PG8_LDA(At, 1, 1); PG8_STAGE(PG8_SB(1, 0), b3, voffB); PG8_STAGE(PG8_SB(1, 1), b3 + hstepB, voffB); PG8_STAGE(PG8_SA(1, 0), a3, voffA);
            PG8_WAIT_V(8); PG8_WAIT_L(0); PG8_BAR; PG8_MMA(1, 0, At, B0); PG8_MMA(1, 1, At, B1); PG8_BAR; PG8_SCHED;
        }
        if constexpr (ALIGN_EPI) { if (wr == 0) PG8_BAR; }
        E(acc, cur, wr, wc, fr, fq);
        if (!has_next) break;
#pragma unroll
        for (int a = 0; a < 2; ++a)
#pragma unroll
            for (int b = 0; b < 2; ++b)
#pragma unroll
                for (int m = 0; m < 4; ++m)
#pragma unroll
                    for (int n = 0; n < 2; ++n) acc[a][b][m][n] = (f32x4){0.f, 0.f, 0.f, 0.f};
        cur = nxt; cA = nA; cB = nB; ++ui;
        if constexpr (ALIGN_EPI) { if (wr == 1) PG8_BAR; }
    }
    PG8_WAIT_V(0);
    if constexpr (!ALIGN_EPI) { if (wr == 0) PG8_BAR; }
    PG8_BAR;
#undef PG8_SA
#undef PG8_SB
#undef PG8_STAGE
#undef PG8_LDA
#undef PG8_LDB
#undef PG8_MMA
#undef PG8_WAIT_V
#undef PG8_WAIT_L
#undef PG8_BAR
#undef PG8_SCHED
}
}

namespace {
using pg8::bf16_t; using pg8::bf16x8; using pg8::f32x4; using pg8::u32x4; using pg8::u32x2; using pg8::Unit; using pg8::cvt_pk_bf16;
#define LAS __attribute__((address_space(3)))
constexpr int NWAVES = 8;
constexpr int RING_BYTES = 131072, LDSCTL_OFF = RING_BYTES, MISC_OFF = LDSCTL_OFF + 320, LDS_BYTES = 147456;

__device__ __forceinline__ unsigned f2bf(float f) { unsigned u = __float_as_uint(f); return (u + 0x7fffu + ((u >> 16) & 1u)) >> 16; }
__device__ __forceinline__ float bf2f(unsigned b) { return __uint_as_float(b << 16); }
__device__ __forceinline__ unsigned pk2(float lo, float hi) { return f2bf(lo) | (f2bf(hi) << 16); }
__device__ __forceinline__ float wave_sum(float v) {
#pragma unroll
    for (int o = 1; o < 64; o <<= 1) v += __shfl_xor(v, o);
    return v;
}
__device__ __forceinline__ float hsum(f32x4 v) { return (v.x + v.y) + (v.z + v.w); }
__device__ __forceinline__ float hsq(f32x4 v) { return (v.x * v.x + v.y * v.y) + (v.z * v.z + v.w * v.w); }

__device__ __forceinline__ const float* xrow_ptr(const Params& p, int t) {
    if (t < TP) { const int b = t / PL, q = t - b * PL; return q < NMETA ? p.meta + (size_t)q * D : p.x_prompt + ((size_t)b * SEQ + (q - NMETA)) * D; }
    return p.x_sample + (size_t)(t - TP) * D;
}
__device__ __forceinline__ float* yrow_ptr(const Params& p, int t) {
    if (t < TP) { const int b = t / PL, q = t - b * PL; return q < NMETA ? nullptr : p.out + O_YP + ((size_t)b * SEQ + (q - NMETA)) * D; }
    if (t < T) return p.out + O_YS + (size_t)(t - TP) * D;
    return nullptr;
}

#define XB_TMO      128
#define XB_XCNT(j)  (256  + 64 * (j))
#define XB_XSUB(j)  (1280 + 64 * (j))
#define XB_XGEN(j)  (2304 + 64 * (j))
#define XB_TOP      3328
#define XB_TOPGEN   3392
#define XCD_BAR_WORDS 3456
#define XB_SPIN_CAP (1u << 18)
__device__ __forceinline__ unsigned xb_ld(unsigned* p)              { return __hip_atomic_load(p, __ATOMIC_RELAXED, __HIP_MEMORY_SCOPE_AGENT); }
__device__ __forceinline__ unsigned xb_add(unsigned* p, unsigned v) { return __hip_atomic_fetch_add(p, v, __ATOMIC_RELAXED, __HIP_MEMORY_SCOPE_AGENT); }
__device__ __forceinline__ unsigned xb_xcc_id() { return (unsigned)__builtin_amdgcn_s_getreg((3 << 11) | 20) & 0xFu; }
#define XB_SPIN(cond, bar) do { unsigned _sp = 0; while (cond) { __builtin_amdgcn_s_sleep(1); \
    if ((++_sp & 255u) == 0u) { if (xb_ld(&(bar)[XB_TMO])) break; if (_sp > XB_SPIN_CAP) { atomicAdd(&(bar)[XB_TMO], 1u); break; } } } } while (0)
struct XcdBarrier { unsigned* bar; unsigned x; volatile LAS unsigned* st; };
__device__ __forceinline__ XcdBarrier xcd_barrier_post(unsigned* bar, volatile LAS unsigned* st) {
    XcdBarrier b; b.bar = bar; b.x = xb_xcc_id(); b.st = st;
    if (threadIdx.x == 0) (void)xb_add(&bar[XB_XCNT(b.x)], 1u);
    return b;
}
__device__ __forceinline__ void xcd_barrier_complete(unsigned* bar, unsigned x, unsigned& nloc, unsigned& nx) {
    const unsigned G = gridDim.x * gridDim.y * gridDim.z;
    unsigned sum, cnt, mine, sp = 0u;
    for (;;) {
        sum = 0u; cnt = 0u; mine = 0u;
#pragma unroll
        for (unsigned j = 0; j < 16; ++j) { const unsigned c = xb_ld(&bar[XB_XCNT(j)]); sum += c; cnt += (c > 0u) ? 1u : 0u; mine = (j == x) ? c : mine; }
        if (sum == G) break;
        __builtin_amdgcn_s_sleep(1);
        if ((++sp & 255u) == 0u) { if (xb_ld(&bar[XB_TMO])) break; if (sp > XB_SPIN_CAP) { atomicAdd(&bar[XB_TMO], 1u); break; } }
    }
    nloc = mine > 0u ? mine : 1u; nx = cnt > 0u ? cnt : 1u;
}
__device__ __forceinline__ void xcd_barrier(const XcdBarrier& b) {
    asm volatile("s_waitcnt vmcnt(0)" ::: "memory");
    __syncthreads();
    if (threadIdx.x == 0) {
        unsigned* bar = b.bar;
        __builtin_amdgcn_s_waitcnt(0);
        unsigned nloc = b.st[0], nx = b.st[1];
        if (nloc == 0u) { xcd_barrier_complete(bar, b.x, nloc, nx); b.st[0] = nloc; b.st[1] = nx; }
        const unsigned old = xb_add(&bar[XB_XSUB(b.x)], 1u);
        const unsigned gen = old / nloc;
        if (old + 1u == (gen + 1u) * nloc) {
            __builtin_amdgcn_fence(__ATOMIC_RELEASE, "agent");
            asm volatile("s_waitcnt vmcnt(0)" ::: "memory");
            const unsigned og = xb_add(&bar[XB_TOP], 1u);
            const unsigned tg = og / nx;
            if (og + 1u == (tg + 1u) * nx) xb_add(&bar[XB_TOPGEN], 1u);
            else XB_SPIN(xb_ld(&bar[XB_TOPGEN]) == tg, bar);
            __builtin_amdgcn_fence(__ATOMIC_ACQUIRE, "agent");
            xb_add(&bar[XB_XGEN(b.x)], 1u);
            asm volatile("s_waitcnt vmcnt(0)" ::: "memory");
        } else {
            XB_SPIN(xb_ld(&bar[XB_XGEN(b.x)]) == gen, bar);
            __builtin_amdgcn_fence(__ATOMIC_ACQUIRE, "agent");
            asm volatile("s_waitcnt vmcnt(0)" ::: "memory");
        }
    }
    __syncthreads();
}

struct EpiIn {
    static constexpr bool PERM = true;
    bf16_t* O; const float* r0;
    __device__ __forceinline__ void operator()(const f32x4 (&acc)[2][2][4][2], const Unit& u, int wr, int wc, int fr, int fq) const {
        const int row0 = u.pm * 256 + wr * 64 + fr, col0 = u.pn * 256 + wc * 32 + 8 * fq;
#pragma unroll
        for (int ai = 0; ai < 2; ++ai)
#pragma unroll
            for (int m = 0; m < 4; ++m) { const int row = row0 + ai * 128 + m * 16; const float sc = r0[row]; bf16_t* rowp = O + (size_t)row * NIN + col0;
#pragma unroll
                for (int bj = 0; bj < 2; ++bj) { const f32x4 v0 = acc[ai][bj][m][0] * sc, v1 = acc[ai][bj][m][1] * sc;
                    u32x4 w; w.x = cvt_pk_bf16(v0[0], v0[1]); w.y = cvt_pk_bf16(v0[2], v0[3]); w.z = cvt_pk_bf16(v1[0], v1[1]); w.w = cvt_pk_bf16(v1[2], v1[3]);
                    *(u32x4*)(rowp + bj * 128) = w; } }
    }
};
struct EpiOut {
    static constexpr bool PERM = true;
    Params p; bf16_t* x1b; float* ssq;
    __device__ __forceinline__ void operator()(const f32x4 (&acc)[2][2][4][2], const Unit& u, int wr, int wc, int fr, int fq) const {
        const int row0 = u.pm * 256 + wr * 64 + fr, col0 = u.pn * 256 + wc * 32 + 8 * fq;
#pragma unroll
        for (int ai = 0; ai < 2; ++ai)
#pragma unroll
            for (int m = 0; m < 4; ++m) { const int row = row0 + ai * 128 + m * 16;
                const float* xr = row < T ? xrow_ptr(p, row) : nullptr; float* yr = yrow_ptr(p, row); float ss = 0.f;
#pragma unroll
                for (int bj = 0; bj < 2; ++bj) { const int col = col0 + bj * 128; f32x4 a0 = acc[ai][bj][m][0], a1 = acc[ai][bj][m][1];
                    if (xr) { a0 += *(const f32x4*)(xr + col); a1 += *(const f32x4*)(xr + col + 4); }
                    if (yr) { *(f32x4*)(yr + col) = a0; *(f32x4*)(yr + col + 4) = a1; }
                    u32x4 w; w.x = cvt_pk_bf16(a0[0], a0[1]); w.y = cvt_pk_bf16(a0[2], a0[3]); w.z = cvt_pk_bf16(a1[0], a1[1]); w.w = cvt_pk_bf16(a1[2], a1[3]);
                    *(u32x4*)(x1b + (size_t)row * D + col) = w; ss += hsq(a0) + hsq(a1); }
                ss += __shfl_xor(ss, 16); ss += __shfl_xor(ss, 32);
                if (fq == 0) ssq[(size_t)row * 16 + u.pn * 4 + wc] = ss; }
    }
};
struct EpiDown {
    static constexpr bool PERM = true;
    Params p; float* ssq;
    __device__ __forceinline__ void operator()(const f32x4 (&acc)[2][2][4][2], const Unit& u, int wr, int wc, int fr, int fq) const {
        const int row0 = u.pm * 256 + wr * 64 + fr, col0 = u.pn * 256 + wc * 32 + 8 * fq;
#pragma unroll
        for (int ai = 0; ai < 2; ++ai)
#pragma unroll
            for (int m = 0; m < 4; ++m) { const int row = row0 + ai * 128 + m * 16; float* yr = yrow_ptr(p, row); float ss = 0.f;
                if (yr) {
#pragma unroll
                    for (int bj = 0; bj < 2; ++bj) { const int col = col0 + bj * 128;
                        const f32x4 a0 = acc[ai][bj][m][0] + *(const f32x4*)(yr + col), a1 = acc[ai][bj][m][1] + *(const f32x4*)(yr + col + 4);
                        *(f32x4*)(yr + col) = a0; *(f32x4*)(yr + col + 4) = a1; ss += hsq(a0) + hsq(a1); } }
                ss += __shfl_xor(ss, 16); ss += __shfl_xor(ss, 32);
                if (fq == 0) ssq[(size_t)row * 16 + u.pn * 4 + wc] = ss; }
    }
};
struct EpiUp {
    static constexpr bool PERM = true;
    const float* cw; const float* cb; const float* state_ffn; float* out; const float* ssq1; bf16_t* act;
    template <int CTRL> static __device__ __forceinline__ float dpp(float x) { return __builtin_bit_cast(float, __builtin_amdgcn_mov_dpp(__builtin_bit_cast(int, x), CTRL, 0xf, 0xf, true)); }
    __device__ __forceinline__ void operator()(const f32x4 (&acc)[2][2][4][2], const Unit& u, int wr, int wc, int fr, int fq) const {
        const int ch0 = u.pn * 128 + wc * 32 + 8 * fq;
#pragma unroll
        for (int ai = 0; ai < 2; ++ai) {
            const int tb = ETILE * u.pm - 2 + EBLK * (2 * ai + wr);
            const bool has_smp = (tb + 63 >= TP);
            float r1[4]; bool k1[4], k2[4]; int foff[4];
#pragma unroll
            for (int m = 0; m < 4; ++m) { const int t = tb + 16 * m + fr; float s = 0.f;
                if (t >= 0) { const f32x4* q = (const f32x4*)(ssq1 + (size_t)t * 16); s = (hsum(q[0]) + hsum(q[1])) + (hsum(q[2]) + hsum(q[3])); }
                r1[m] = t >= 0 ? rsqrtf(s * (1.f / D) + EPS) : 0.f;
                int pos, fo = -1; const bool valid = (m > 0 || fr >= 2) && t < T;
                if (t < TP) { const int b = t / PL; pos = t - b * PL; if (valid && pos >= PL - 2) fo = (int)O_FP + (b * 2 + (pos - (PL - 2))) * NUP; }
                else { pos = (t - TP) & 3; const int sq = (t - TP) >> 2; if (valid && pos >= 2) fo = (int)O_FS + (sq * 2 + (pos - 2)) * NUP; }
                k1[m] = pos >= 1; k2[m] = pos >= 2; foff[m] = fo; }
            unsigned ov[4][4];
#pragma unroll
            for (int c4 = 0; c4 < 4; ++c4) { const int n = c4 >> 1, eh = c4 & 1, ch = ch0 + 2 * c4;
                const float2 w0v = *(const float2*)(cw + ch), w1v = *(const float2*)(cw + NUP + ch), w2v = *(const float2*)(cw + 2 * NUP + ch), bv = *(const float2*)(cb + ch);
                const float2 w0g = *(const float2*)(cw + DFF + ch), w1g = *(const float2*)(cw + NUP + DFF + ch), w2g = *(const float2*)(cw + 2 * NUP + DFF + ch), bg = *(const float2*)(cb + DFF + ch);
                float pr1v[2] = {0.f, 0.f}, pr2v[2] = {0.f, 0.f}, pr1g[2] = {0.f, 0.f}, pr2g[2] = {0.f, 0.f};
#pragma unroll
                for (int m = 0; m < 4; ++m) { const int t = tb + 16 * m + fr;
                    float s1v[2] = {0.f, 0.f}, s2v[2] = {0.f, 0.f}, s1g[2] = {0.f, 0.f}, s2g[2] = {0.f, 0.f};
                    if (has_smp) { if (t >= TP && t < T) { const int j = (t - TP) & 3, sq = (t - TP) >> 2;
                        if (j < 2) { const float* st = state_ffn + ((size_t)sq * 2 + j) * NUP + ch; const float2 a = *(const float2*)st, b = *(const float2*)(st + DFF); s2v[0] = a.x; s2v[1] = a.y; s2g[0] = b.x; s2g[1] = b.y; }
                        if (j == 0) { const float* st = state_ffn + ((size_t)sq * 2 + 1) * NUP + ch; const float2 a = *(const float2*)st, b = *(const float2*)(st + DFF); s1v[0] = a.x; s1v[1] = a.y; s1g[0] = b.x; s1g[1] = b.y; } } }
                    float av[2], Vvs[2], Vgs[2];
#pragma unroll
                    for (int e = 0; e < 2; ++e) {
                        const float Vv = acc[ai][0][m][n][2 * eh + e] * r1[m], Vg = acc[ai][1][m][n][2 * eh + e] * r1[m];
                        const float c1v = dpp<0x121>(Vv), c2v = dpp<0x122>(Vv), c1g = dpp<0x121>(Vg), c2g = dpp<0x122>(Vg);
                        float p1v = fr >= 1 ? c1v : pr1v[e], p2v = fr >= 2 ? c2v : pr2v[e], p1g = fr >= 1 ? c1g : pr1g[e], p2g = fr >= 2 ? c2g : pr2g[e];
                        pr1v[e] = c1v; pr2v[e] = c2v; pr1g[e] = c1g; pr2g[e] = c2g;
                        p1v = k1[m] ? p1v : s1v[e]; p1g = k1[m] ? p1g : s1g[e]; p2v = k2[m] ? p2v : s2v[e]; p2g = k2[m] ? p2g : s2g[e];
                        const float wv0 = e ? w0v.y : w0v.x, wv1 = e ? w1v.y : w1v.x, wv2 = e ? w2v.y : w2v.x, bvv = e ? bv.y : bv.x;
                        const float wg0 = e ? w0g.y : w0g.x, wg1 = e ? w1g.y : w1g.x, wg2 = e ? w2g.y : w2g.x, bgg = e ? bg.y : bg.x;
                        const float val = wv0 * p2v + wv1 * p1v + wv2 * Vv + bvv, gate = wg0 * p2g + wg1 * p1g + wg2 * Vg + bgg;
                        av[e] = val * gate / (1.f + __expf(-gate)); Vvs[e] = Vv; Vgs[e] = Vg; }
                    ov[m][c4] = cvt_pk_bf16(av[0], av[1]);
                    if (foff[m] >= 0) { float* o = out + foff[m] + ch; float2 a; a.x = Vvs[0]; a.y = Vvs[1]; *(float2*)o = a; float2 b; b.x = Vgs[0]; b.y = Vgs[1]; *(float2*)(o + DFF) = b; }
                } }
#pragma unroll
            for (int m = 0; m < 4; ++m) { const int t = tb + 16 * m + fr; const bool valid = (m > 0 || fr >= 2) && t < T;
                if (valid) { u32x4 w; w.x = ov[m][0]; w.y = ov[m][1]; w.z = ov[m][2]; w.w = ov[m][3]; *(u32x4*)(act + (size_t)t * DFF + ch0) = w; } }
        }
    }
};

__device__ __forceinline__ int wup_src_col(int n) { const int pn = n >> 8, w = n & 255, bj = w >> 7, c = w & 127; return bj * DFF + 128 * pn + c; }
template <bool MAP>
__device__ __forceinline__ void p0_transpose_item(const float* W, int K, int N, int NP, bf16_t* WT, const float* gain, LAS float* scr, int item, int lane) {
    const int nblk = NP / 32, kb = item / nblk, nb = item % nblk, k0 = 64 * kb, n0 = 32 * nb, s0 = MAP ? wup_src_col(n0) : n0;
#pragma unroll 8
    for (int i = 0; i < 32; ++i) { const int kk = 2 * i + (lane >> 5); float v = W[(size_t)(k0 + kk) * N + s0 + (lane & 31)]; if (gain) v *= gain[k0 + kk]; scr[kk * 33 + (lane & 31)] = v; }
    asm volatile("s_waitcnt lgkmcnt(0)" ::: "memory");
    const int c = lane & 7;
#pragma unroll
    for (int j = 0; j < 4; ++j) { const int n = (lane >> 3) + 8 * j; const LAS float* s = scr + (8 * c) * 33 + n;
        u32x4 o; o.x = pk2(s[0 * 33], s[1 * 33]); o.y = pk2(s[2 * 33], s[3 * 33]); o.z = pk2(s[4 * 33], s[5 * 33]); o.w = pk2(s[6 * 33], s[7 * 33]);
        *(u32x4*)(WT + (size_t)(n0 + n) * K + k0 + 8 * c) = o; }
    asm volatile("s_waitcnt lgkmcnt(0)" ::: "memory");
}
__device__ __forceinline__ void p0_prologue(const Params& p, LAS unsigned char* lds, int gw, int NGW, int wave, int lane) {
    LAS float* scr = (LAS float*)(lds + wave * 16384);
    bf16_t* win = (bf16_t*)(p.ws + WS_WIN); bf16_t* wout = (bf16_t*)(p.ws + WS_WOUT); bf16_t* wup = (bf16_t*)(p.ws + WS_WUP); bf16_t* wdown = (bf16_t*)(p.ws + WS_WDOWN); bf16_t* wpool = (bf16_t*)(p.ws + WS_WPOOL);
    constexpr int I_IN = (D / 64) * (NIN / 32), I_OUT = (D / 64) * (D / 32), I_UP = (D / 64) * (NUP / 32), I_DN = (DFF / 64) * (D / 32), I_PL = 4 * (128 / 64) * (128 / 32);
    constexpr int NITEMS = I_IN + I_OUT + I_UP + I_DN + I_PL;
    for (int it = gw; it < NITEMS; it += NGW) {
        int r = it;
        if (r < I_UP) { p0_transpose_item<true>(p.w_up, D, NUP, NUP, wup, p.norm_ffn, scr, r, lane); continue; } r -= I_UP;
        if (r < I_DN) { p0_transpose_item<false>(p.w_down, DFF, D, D, wdown, nullptr, scr, r, lane); continue; } r -= I_DN;
        if (r < I_IN) { p0_transpose_item<false>(p.w_in, D, NIN, NIN, win, p.norm_mix, scr, r, lane); continue; } r -= I_IN;
        if (r < I_OUT) { p0_transpose_item<false>(p.w_out, D, D, D, wout, nullptr, scr, r, lane); continue; } r -= I_OUT;
        { const int g = r >> 3; p0_transpose_item<false>(p.w_pool + (size_t)g * 16384, 128, 128, 128, wpool + (size_t)g * 16384, nullptr, scr, r & 7, lane); }
    }
    bf16_t* xb = (bf16_t*)(p.ws + WS_XB); float* r0 = (float*)(p.ws + WS_R0); bf16_t* mix = (bf16_t*)(p.ws + WS_MIX); bf16_t* x1b = (bf16_t*)(p.ws + WS_X1B);
    for (int t = gw; t < MPAD + X1B_PADROWS; t += NGW) {
        if (t >= MPAD) { unsigned long long* o8 = (unsigned long long*)(x1b + (size_t)(t - MPAD) * D) + lane; for (int j = 0; j < 4; ++j) o8[64 * j] = 0ull; continue; }
        unsigned long long* o8 = (unsigned long long*)(xb + (size_t)t * D) + lane;
        if (t >= T) { unsigned long long* m8 = (unsigned long long*)(mix + (size_t)t * D) + lane; for (int j = 0; j < 4; ++j) { o8[64 * j] = 0ull; m8[64 * j] = 0ull; } if (lane == 0) r0[t] = 0.f; continue; }
        const f32x4* xr = (const f32x4*)xrow_ptr(p, t) + lane;
        f32x4 v[4]; float s = 0.f;
#pragma unroll
        for (int j = 0; j < 4; ++j) { v[j] = xr[64 * j]; s += hsq(v[j]); }
        s = wave_sum(s);
        if (lane == 0) r0[t] = rsqrtf(s * (1.f / D) + EPS);
#pragma unroll
        for (int j = 0; j < 4; ++j) o8[64 * j] = (unsigned long long)pk2(v[j].x, v[j].y) | ((unsigned long long)pk2(v[j].z, v[j].w) << 32);
    }
}

constexpr int MIX_ROWB = 272;
template <int W>
__device__ __forceinline__ void pool_prompt_tile(const Params& p, const bf16_t* proj, LAS unsigned char* scr, int t0, int b, int p0, int g, int lane) {
    const int cu = 128 * g + 2 * lane;
    float ua[31], ub[31];
#pragma unroll
    for (int dr = 0; dr < 31; ++dr) { const int r = p0 - 15 + dr; unsigned w = 0u; if (r >= 0) w = *(const unsigned*)(proj + (size_t)(t0 - 15 + dr) * NIN + cu); ua[dr] = bf2f(w & 0xffffu); ub[dr] = bf2f(w >> 16); }
    float ca[32], cb2[32]; ca[0] = 0.f; cb2[0] = 0.f;
#pragma unroll
    for (int dr = 0; dr < 31; ++dr) { ca[dr + 1] = ca[dr] + ua[dr]; cb2[dr + 1] = cb2[dr] + ub[dr]; }
#pragma unroll
    for (int i = 0; i < 16; ++i) {
        const int pos = p0 + i; const float inv = 1.f / (float)(pos + 1 < W ? pos + 1 : W);
        const float da = (ca[16 + i] - ca[16 + i - W]) * inv - ua[15 + i], db = (cb2[16 + i] - cb2[16 + i - W]) * inv - ub[15 + i];
        *(LAS unsigned*)(scr + i * MIX_ROWB + 4 * lane) = pk2(da, db);
        if (pos >= PL - PBUF) { float2 o; o.x = ua[15 + i]; o.y = ub[15 + i]; *(float2*)(p.out + O_PP + ((size_t)b * PBUF + (pos - (PL - PBUF))) * POOLW + cu) = o; }
    }
}
__device__ __forceinline__ void mixer_phase(const Params& p, LAS unsigned char* lds, int gw, int NGW, int wave, int lane) {
    LAS unsigned char* scr = lds + wave * 8192;
    const bf16_t* proj = (const bf16_t*)(p.ws + WS_PROJ); bf16_t* mix = (bf16_t*)(p.ws + WS_MIX); const bf16_t* wpool = (const bf16_t*)(p.ws + WS_WPOOL);
    const int fr = lane & 15, fq = lane >> 4;
    constexpr int NITEM = (T / 16) * 4;
    for (int it = gw; it < NITEM; it += NGW) {
        const int tt = it >> 2, qd = it & 3, t0 = 16 * tt, g = qd, cu = 128 * g + 2 * lane, cc = 128 * qd + 2 * lane;
        if (t0 < TP) {
            const int b = t0 / PL, p0 = t0 - b * PL;
            if (g == 0) pool_prompt_tile<2>(p, proj, scr, t0, b, p0, g, lane);
            else if (g == 1) pool_prompt_tile<4>(p, proj, scr, t0, b, p0, g, lane);
            else if (g == 2) pool_prompt_tile<8>(p, proj, scr, t0, b, p0, g, lane);
            else pool_prompt_tile<16>(p, proj, scr, t0, b, p0, g, lane);
            float za[18], zb[18];
#pragma unroll
            for (int dr = 0; dr < 18; ++dr) { const int r = p0 - 2 + dr; unsigned wc_ = 0u, wv = 0u;
                if (r >= 0) { const bf16_t* row = proj + (size_t)(t0 - 2 + dr) * NIN; wc_ = *(const unsigned*)(row + 1024 + cc); wv = *(const unsigned*)(row + 1536 + cc); }
                za[dr] = bf2f(wc_ & 0xffffu) * bf2f(wv & 0xffffu); zb[dr] = bf2f(wc_ >> 16) * bf2f(wv >> 16); }
            const float2 w0 = *(const float2*)(p.conv_w + cc), w1 = *(const float2*)(p.conv_w + CONVW + cc), w2 = *(const float2*)(p.conv_w + 2 * CONVW + cc);
#pragma unroll
            for (int i = 0; i < 16; ++i) { const unsigned wg = *(const unsigned*)(proj + (size_t)(t0 + i) * NIN + 512 + cc);
                const float ca_ = w0.x * za[i] + w1.x * za[i + 1] + w2.x * za[i + 2], cb_ = w0.y * zb[i] + w1.y * zb[i + 1] + w2.y * zb[i + 2];
                *(unsigned*)(mix + (size_t)(t0 + i) * D + 512 + cc) = pk2(bf2f(wg & 0xffffu) * ca_, bf2f(wg >> 16) * cb_);
                const int pos = p0 + i; if (pos >= PL - 2) { float2 o; o.x = za[i + 2]; o.y = zb[i + 2]; *(float2*)(p.out + O_CP + ((size_t)b * 2 + (pos - (PL - 2))) * CONVW + cc) = o; } }
        } else {
            const int s0 = (t0 - TP) >> 2, W = 2 << g;
            for (int i = 0; i < 16; ++i) { const int sq = s0 + (i >> 2), j = i & 3, t = t0 + i; float sa = 0.f, sb = 0.f;
                for (int k = 0; k < W; ++k) { const int q = j - k;
                    if (q >= 0) { const unsigned w = *(const unsigned*)(proj + (size_t)(t - k) * NIN + cu); sa += bf2f(w & 0xffffu); sb += bf2f(w >> 16); }
                    else { const float2 s = *(const float2*)(p.state_pool + ((size_t)sq * PBUF + (PBUF + q)) * POOLW + cu); sa += s.x; sb += s.y; } }
                const unsigned w = *(const unsigned*)(proj + (size_t)t * NIN + cu); const float ua = bf2f(w & 0xffffu), ub = bf2f(w >> 16), inv = 1.f / (float)W;
                *(LAS unsigned*)(scr + i * MIX_ROWB + 4 * lane) = pk2(sa * inv - ua, sb * inv - ub);
                { float2 o; o.x = ua; o.y = ub; *(float2*)(p.out + O_PS + ((size_t)sq * PBUF + (PBUF - DS + j)) * POOLW + cu) = o; }
                float za[3], zb[3];
#pragma unroll
                for (int ii = 0; ii < 3; ++ii) { const int q = j - 2 + ii;
                    if (q >= 0) { const bf16_t* row = proj + (size_t)(t - 2 + ii) * NIN; const unsigned wc_ = *(const unsigned*)(row + 1024 + cc), wv = *(const unsigned*)(row + 1536 + cc);
                        za[ii] = bf2f(wc_ & 0xffffu) * bf2f(wv & 0xffffu); zb[ii] = bf2f(wc_ >> 16) * bf2f(wv >> 16); }
                    else { const float2 s = *(const float2*)(p.state_conv + ((size_t)sq * 2 + (2 + q)) * CONVW + cc); za[ii] = s.x; zb[ii] = s.y; } }
                const float2 w0 = *(const float2*)(p.conv_w + cc), w1 = *(const float2*)(p.conv_w + CONVW + cc), w2 = *(const float2*)(p.conv_w + 2 * CONVW + cc);
                const unsigned wg = *(const unsigned*)(proj + (size_t)t * NIN + 512 + cc);
                const float ca_ = w0.x * za[0] + w1.x * za[1] + w2.x * za[2], cb_ = w0.y * zb[0] + w1.y * zb[1] + w2.y * zb[2];
                *(unsigned*)(mix + (size_t)t * D + 512 + cc) = pk2(bf2f(wg & 0xffffu) * ca_, bf2f(wg >> 16) * cb_);
                if (j >= DS - 2) { float2 o; o.x = za[2]; o.y = zb[2]; *(float2*)(p.out + O_CS + ((size_t)sq * 2 + (j - (DS - 2))) * CONVW + cc) = o; }
            }
            for (int q = 0; q < 4; ++q) for (int r = 0; r < PBUF - DS; ++r)
                *(float2*)(p.out + O_PS + ((size_t)(s0 + q) * PBUF + r) * POOLW + cu) = *(const float2*)(p.state_pool + ((size_t)(s0 + q) * PBUF + r + DS) * POOLW + cu);
        }
        asm volatile("s_waitcnt lgkmcnt(0)" ::: "memory");
        bf16x8 af[4];
#pragma unroll
        for (int s = 0; s < 4; ++s) af[s] = *(const LAS bf16x8*)(scr + fr * MIX_ROWB + (32 * s + 8 * fq) * 2);
#pragma unroll
        for (int nb = 0; nb < 8; ++nb) { f32x4 a = (f32x4){0.f, 0.f, 0.f, 0.f};
#pragma unroll
            for (int s = 0; s < 4; ++s) { const bf16x8 bfr = *(const bf16x8*)(wpool + ((size_t)(g * 128 + 16 * nb + fr)) * 128 + 32 * s + 8 * fq); a = __builtin_amdgcn_mfma_f32_16x16x32_bf16(bfr, af[s], a, 0, 0, 0); }
            const int col = 128 * g + 16 * nb + 4 * fq; const f32x4 sc = *(const f32x4*)(p.pool_scale + col); a = a * sc;
            u32x2 o; o.x = cvt_pk_bf16(a[0], a[1]); o.y = cvt_pk_bf16(a[2], a[3]); *(u32x2*)(mix + (size_t)(t0 + fr) * D + col) = o; }
        asm volatile("s_waitcnt lgkmcnt(0)" ::: "memory");
    }
}

__device__ __forceinline__ void final_phase(const Params& p, int gw, int NGW, int lane) {
    const float* ssq2 = (const float*)(p.ws + WS_SSQ2);
    f32x4 gv[4];
#pragma unroll
    for (int j = 0; j < 4; ++j) gv[j] = *((const f32x4*)p.norm_final + lane + 64 * j);
    for (int t = gw; t < T; t += NGW) {
        float* y = yrow_ptr(p, t); if (!y) continue;
        const f32x4* q = (const f32x4*)(ssq2 + (size_t)t * 16); const float s = (hsum(q[0]) + hsum(q[1])) + (hsum(q[2]) + hsum(q[3]));
        const float r = rsqrtf(s * (1.f / D) + EPS);
        f32x4* yr = (f32x4*)y + lane;
#pragma unroll
        for (int j = 0; j < 4; ++j) { const f32x4 v = yr[64 * j]; yr[64 * j] = v * r * gv[j]; }
    }
}

struct Args { Params p; };
__global__ void __launch_bounds__(NWAVES * 64, 2) fwd_megakernel(Args args) {
    extern __shared__ __attribute__((aligned(16))) unsigned char lds_raw[];
    LAS unsigned char* lds = (LAS unsigned char*)lds_raw;
    const Params& p = args.p;
    const int tid = threadIdx.x, lane = tid & 63, wave = __builtin_amdgcn_readfirstlane(tid >> 6);
    const int G = gridDim.x, bx = blockIdx.x, vcu = (G % 8 == 0) ? (bx % 8) * (G / 8) + bx / 8 : bx;
    const int gw = vcu * NWAVES + wave, NGW = G * NWAVES;
    unsigned* ctl = (unsigned*)(p.ws + WS_CTL);
    for (int u = tid; u < (LDS_BYTES - LDSCTL_OFF) / 4; u += NWAVES * 64) ((LAS unsigned*)(lds + LDSCTL_OFF))[u] = 0u;
    __syncthreads();
    const XcdBarrier bar = xcd_barrier_post(ctl + CW_BAR, (volatile LAS unsigned*)(lds + MISC_OFF) + 8);

    p0_prologue(p, lds, gw, NGW, wave, lane);
    xcd_barrier(bar);
    { pg8::Gemm g{(const bf16_t*)(p.ws + WS_XB), (const bf16_t*)(p.ws + WS_WIN), D, 64}; pg8::StaticOrder S; S.init(NM, NIN / 256, G, bx);
      EpiIn E{(bf16_t*)(p.ws + WS_PROJ), (const float*)(p.ws + WS_R0)};
      pg8::gemm_phase<EpiIn, true>(lds, g, S, E); }
    xcd_barrier(bar);
    mixer_phase(p, lds, gw, NGW, wave, lane);
    xcd_barrier(bar);
    { pg8::Gemm g{(const bf16_t*)(p.ws + WS_MIX), (const bf16_t*)(p.ws + WS_WOUT), D, 64}; pg8::StaticOrder S; S.init(NM, D / 256, G, bx);
      EpiOut E{p, (bf16_t*)(p.ws + WS_X1B) + (size_t)X1B_PADROWS * D, (float*)(p.ws + WS_SSQ1)};
      pg8::gemm_phase<EpiOut, true>(lds, g, S, E); }
    xcd_barrier(bar);
    { pg8::Gemm g{(const bf16_t*)(p.ws + WS_X1B) + (size_t)(X1B_PADROWS - 2) * D, (const bf16_t*)(p.ws + WS_WUP), D, EBLK}; pg8::StaticOrder S; S.init(NME, NUP / 256, G, bx);
      EpiUp E{p.ffn_conv_w, p.ffn_conv_b, p.state_ffn, p.out, (const float*)(p.ws + WS_SSQ1), (bf16_t*)(p.ws + WS_ACT)};
      pg8::gemm_phase<EpiUp, true>(lds, g, S, E); }
    xcd_barrier(bar);
    { pg8::Gemm g{(const bf16_t*)(p.ws + WS_ACT), (const bf16_t*)(p.ws + WS_WDOWN), DFF, 64}; pg8::StaticOrder S; S.init(NM, D / 256, G, bx);
      EpiDown E{p, (float*)(p.ws + WS_SSQ2)};
      pg8::gemm_phase<EpiDown, true>(lds, g, S, E); }
    xcd_barrier(bar);
    final_phase(p, gw, NGW, lane);
}
}

extern "C" void kernel_launch(void* const* d_in, const int* in_sizes, int n_in, void* d_out, int out_size, void* d_ws, size_t ws_size, hipStream_t stream) {
    static int grid = 0;
    if (grid == 0) {
        if (n_in != 18 || ws_size < WS_END) { fprintf(stderr, "kernel_launch: unexpected inputs (n_in %d, ws %zu)\n", n_in, ws_size); grid = -1; return; }
        int dev = 0, cus = 0, per_cu = 0;
        if (hipGetDevice(&dev) != hipSuccess || hipDeviceGetAttribute(&cus, hipDeviceAttributeMultiprocessorCount, dev) != hipSuccess) { grid = -1; return; }
        if (hipFuncSetAttribute((const void*)fwd_megakernel, hipFuncAttributeMaxDynamicSharedMemorySize, LDS_BYTES) != hipSuccess) { fprintf(stderr, "kernel_launch: hipFuncSetAttribute failed\n"); grid = -1; return; }
        if (hipOccupancyMaxActiveBlocksPerMultiprocessor(&per_cu, (const void*)fwd_megakernel, NWAVES * 64, LDS_BYTES) != hipSuccess || per_cu < 1)
            fprintf(stderr, "kernel_launch: note: occupancy query reports %d workgroups per CU\n", per_cu);
        (void)hipGetLastError();
        grid = cus;
    }
    if (grid < 0) return;
    (void)hipMemsetAsync((char*)d_ws + WS_CTL, 0, CTL_ZERO_BYTES, stream);
    Args a{};
    Params& p = a.p;
    p.x_prompt = (const float*)d_in[0]; p.x_sample = (const float*)d_in[1]; p.state_pool = (const float*)d_in[2]; p.state_conv = (const float*)d_in[3]; p.state_ffn = (const float*)d_in[4];
    p.meta = (const float*)d_in[5]; p.norm_mix = (const float*)d_in[6]; p.w_in = (const float*)d_in[7]; p.w_pool = (const float*)d_in[8]; p.pool_scale = (const float*)d_in[9];
    p.conv_w = (const float*)d_in[10]; p.w_out = (const float*)d_in[11]; p.norm_ffn = (const float*)d_in[12]; p.w_up = (const float*)d_in[13]; p.ffn_conv_w = (const float*)d_in[14];
    p.ffn_conv_b = (const float*)d_in[15]; p.w_down = (const float*)d_in[16]; p.norm_final = (const float*)d_in[17];
    p.out = (float*)d_out; p.ws = (unsigned char*)d_ws;
    hipLaunchKernelGGL(fwd_megakernel, dim3(grid), dim3(NWAVES * 64), LDS_BYTES, stream, a);
    const hipError_t le = hipPeekAtLastError();
    if (le != hipSuccess) fprintf(stderr, "kernel_launch: launch failed: %s\n", hipGetErrorName(le));
}
```

```cpp
#include <hip/hip_runtime.h>
#include <cstdio>
#include <cstdint>

namespace {
constexpr int D = 1024, NB = 8, SEQ = 2048, NMETA = 16, PL = SEQ + NMETA, TP = NB * PL, DB = 128, DS = 4, TS = DB * DS, T = TP + TS;
constexpr int MPAD = 17152;
constexpr int POOLW = 512, CONVW = 512, NIN = 2048, DFF = 2816, NUP = 5632, PBUF = 15;
constexpr float EPS = 1e-6f;
constexpr int NM = MPAD / 256;
constexpr int EBLK = 62, ETILE = 4 * EBLK;
constexpr int NME = (T + ETILE - 1) / ETILE;
constexpr size_t O_YP = 0, O_YS = (size_t)NB * SEQ * D, O_PP = O_YS + (size_t)TS * D, O_CP = O_PP + (size_t)NB * PBUF * POOLW,
                 O_FP = O_CP + (size_t)NB * 2 * CONVW, O_PS = O_FP + (size_t)NB * 2 * NUP, O_CS = O_PS + (size_t)DB * PBUF * POOLW,
                 O_FS = O_CS + (size_t)DB * 2 * CONVW;
constexpr size_t MiB = 1u << 20;
constexpr size_t WS_CTL = 0, CTL_ZERO_BYTES = 64 * 1024;
constexpr size_t WS_R0 = 256 * 1024;
constexpr size_t WS_SSQ1 = 2 * MiB, WS_SSQ2 = 4 * MiB;
constexpr size_t WS_WIN = 6 * MiB, WS_WOUT = 10 * MiB, WS_WUP = 12 * MiB, WS_WDOWN = 23 * MiB, WS_WPOOL = 29 * MiB;
constexpr size_t WS_MIX = 30 * MiB, WS_X1B = 64 * MiB, WS_XB = 98 * MiB, WS_PROJ = 132 * MiB, WS_ACT = 98 * MiB, WS_END = 200 * MiB;
constexpr int X1B_PADROWS = 16;
static_assert(WS_MIX + (size_t)MPAD * D * 2 <= WS_X1B && WS_X1B + (size_t)(MPAD + X1B_PADROWS) * D * 2 <= WS_XB && WS_XB + (size_t)MPAD * D * 2 <= WS_PROJ &&
              WS_PROJ + (size_t)MPAD * NIN * 2 <= WS_END && WS_ACT + (size_t)MPAD * DFF * 2 <= WS_END && WS_WUP + (size_t)NUP * D * 2 <= WS_WDOWN && WS_WDOWN + (size_t)D * DFF * 2 <= WS_WPOOL, "d_ws map");
constexpr int CW_BAR = 1024;

struct Params {
    const float *x_prompt, *x_sample, *state_pool, *state_conv, *state_ffn, *meta, *norm_mix, *w_in, *w_pool, *pool_scale, *conv_w, *w_out,
        *norm_ffn, *w_up, *ffn_conv_w, *ffn_conv_b, *w_down, *norm_final;
    float* out; unsigned char* ws;
};
}

namespace pg8 {
#define PG8_LAS __attribute__((address_space(3)))
typedef unsigned short bf16_t;
typedef short bf16x8 __attribute__((ext_vector_type(8)));
typedef float f32x4 __attribute__((ext_vector_type(4)));
typedef unsigned u32x4 __attribute__((ext_vector_type(4)));
typedef unsigned u32x2 __attribute__((ext_vector_type(2)));
constexpr int BM = 256, BK = 64, HALF = 128, HTB = HALF * BK * 2  , STAGE_BYTES = 8 * HTB, NXCD = 8, WGM = 8;

__host__ __device__ __forceinline__ int lds_byte(int r, int c) { const int st = (r >> 4) * 2 + (c >> 5), rr = r & 15, cc = c & 31, ob = rr * 64 + cc * 2; return st * 1024 + (ob ^ (((ob >> 9) & 1) << 5)); }
__host__ __device__ __forceinline__ void stage_rc(int b, int& R, int& C) { const int st = b / 1024, sb = b % 1024, swz = sb ^ (((sb >> 9) & 1) << 5); R = (st >> 1) * 16 + swz / 64; C = (st & 1) * 32 + (swz % 64) / 2; }
__host__ __device__ __forceinline__ int perm32(int rho) { const int n = rho >> 4, i = rho & 15; return 8 * (i >> 2) + 4 * n + (i & 3); }

struct Unit { int pm, pn; };
struct Gemm { const bf16_t* A; const bf16_t* Bt; int K; int ablk; };

struct StaticOrder {
    int nM, nN, nwg, G, c;
    __host__ __device__ void init(int nM_, int nN_, int G_, int c_) { nM = nM_; nN = nN_; nwg = nM * nN; G = G_; c = c_; }
    __host__ __device__ bool next(int i, Unit& u) const {
        const long L = (long)i * G + c; if (L >= nwg) return false;
        int wgid = (int)L; { const int q = nwg / NXCD, r = nwg % NXCD, xcd = wgid % NXCD, off = wgid / NXCD; wgid = (xcd < r ? xcd * (q + 1) : r * (q + 1) + (xcd - r) * q) + off; }
        const int nig = WGM * nN, gid = wgid / nig, fm = gid * WGM, gsz = (nM - fm) < WGM ? (nM - fm) : WGM;
        u.pm = fm + ((wgid % nig) % gsz); u.pn = (wgid % nig) / gsz; return true;
    }
};

__device__ __forceinline__ unsigned cvt_pk_bf16(float lo, float hi) { unsigned r; asm volatile("v_cvt_pk_bf16_f32 %0, %1, %2" : "=v"(r) : "v"(lo), "v"(hi)); return r; }
__device__ __forceinline__ int lane_id_fresh() { int l; asm volatile("v_mbcnt_lo_u32_b32 %0, -1, 0\n\tv_mbcnt_hi_u32_b32 %0, -1, %0" : "=v"(l)); return l; }

template <class Epi, bool ALIGN_EPI>
__device__ __forceinline__ void gemm_phase(PG8_LAS unsigned char* lds, const Gemm g, const StaticOrder& S, const Epi& E, const int wave_id) {
    const int wid = wave_id, lane = lane_id_fresh(), tid = wid * 64 + lane, wr = wid >> 2, wc = wid & 3, fr = lane & 15, fq = lane >> 4;
    const int K = g.K, nt = K / BK;
    unsigned voffA[2], voffB[2];
#pragma unroll
    for (int i = 0; i < 2; ++i) { int R, C; stage_rc(tid * 16 + i * 8192, R, C); const int Rb = Epi::PERM ? ((R & ~31) + perm32(R & 31)) : R; const int Ra = (R >> 6) * g.ablk + (R & 63);
        voffA[i] = (unsigned)(Ra * K + C) * 2u; voffB[i] = (unsigned)(Rb * K + C) * 2u; }
    const size_t kstep = (size_t)(BK * 2);
    const size_t hstepB = (size_t)HALF * K * 2, tstepB = 2 * hstepB;
    const size_t hstepA = (size_t)2 * g.ablk * K * 2, tstepA = 2 * hstepA;
    const unsigned ldsw = (unsigned)wid * 1024u;
    const int aoff = lds_byte(wr * 64 + fr, fq * 8), boff = lds_byte(wc * 32 + fr, fq * 8);
#define PG8_SA(b, h) (((b) * 2 + (h)) * HTB)
#define PG8_SB(b, h) ((4 + (b) * 2 + (h)) * HTB)
#define PG8_STAGE(bufoff, gbase, voff) do { _Pragma("unroll") for (int _i = 0; _i < 2; ++_i) \
        __builtin_amdgcn_global_load_lds((const unsigned*)((const char*)(gbase) + (voff)[_i]), (PG8_LAS unsigned*)(lds + (bufoff) + ldsw + _i * 8192), 16, 0, 0); } while (0)
#define PG8_LDA(dst, b, h) do { _Pragma("unroll") for (int m = 0; m < 4; ++m) _Pragma("unroll") for (int k = 0; k < 2; ++k) dst[m][k] = *(const PG8_LAS bf16x8*)(lds + PG8_SA(b, h) + aoff + m * 2048 + k * 1024); } while (0)
#define PG8_LDB(dst, b, h) do { _Pragma("unroll") for (int n = 0; n < 2; ++n) _Pragma("unroll") for (int k = 0; k < 2; ++k) dst[n][k] = *(const PG8_LAS bf16x8*)(lds + PG8_SB(b, h) + boff + n * 2048 + k * 1024); } while (0)
#define PG8_MMA(ai, bj, At, Bt) do { __builtin_amdgcn_s_setprio(1); _Pragma("unroll") for (int m = 0; m < 4; ++m) _Pragma("unroll") for (int n = 0; n < 2; ++n) _Pragma("unroll") for (int k = 0; k < 2; ++k) \
        acc[ai][bj][m][n] = __builtin_amdgcn_mfma_f32_16x16x32_bf16(Bt[n][k], At[m][k], acc[ai][bj][m][n], 0, 0, 0); __builtin_amdgcn_s_setprio(0); } while (0)
#define PG8_WAIT_V(n) asm volatile("s_waitcnt vmcnt(" #n ")" ::: "memory")
#define PG8_WAIT_L(n) asm volatile("s_waitcnt lgkmcnt(" #n ")" ::: "memory")
#define PG8_BAR __builtin_amdgcn_s_barrier()
#define PG8_SCHED __builtin_amdgcn_sched_barrier(0)
    Unit cur, nxt; int ui = 0;
    if (!S.next(0, cur)) return;
    f32x4 acc[2][2][4][2];
#pragma unroll
    for (int a = 0; a < 2; ++a)
#pragma unroll
        for (int b = 0; b < 2; ++b)
#pragma unroll
            for (int m = 0; m < 4; ++m)
#pragma unroll
                for (int n = 0; n < 2; ++n) acc[a][b][m][n] = (f32x4){0.f, 0.f, 0.f, 0.f};
    bf16x8 At[4][2], B0[2][2], B1[2][2];
    const char* cA = (const char*)g.A + (size_t)cur.pm * tstepA; const char* cB = (const char*)g.Bt + (size_t)cur.pn * tstepB;
    PG8_STAGE(PG8_SB(0, 0), cB, voffB); PG8_STAGE(PG8_SB(0, 1), cB + hstepB, voffB); PG8_STAGE(PG8_SA(0, 0), cA, voffA); PG8_STAGE(PG8_SA(0, 1), cA + hstepA, voffA);
    if (wr == 1) PG8_BAR;
    PG8_WAIT_V(2); PG8_BAR;
    PG8_STAGE(PG8_SB(1, 0), cB + kstep, voffB); PG8_STAGE(PG8_SA(1, 0), cA + kstep, voffA); PG8_STAGE(PG8_SB(1, 1), cB + hstepB + kstep, voffB);
    PG8_WAIT_V(6); PG8_BAR;
    for (;;) {
        const bool has_next = S.next(ui + 1, nxt);
        const char* nA = has_next ? (const char*)g.A + (size_t)nxt.pm * tstepA : cA; const char* nB = has_next ? (const char*)g.Bt + (size_t)nxt.pn * tstepB : cB;
        for (int t = 0; t < nt; t += 2) {
            const bool last = (t == nt - 2);
            const char* a1 = cA + (size_t)(t + 1) * kstep;
            const char* a2 = last ? nA : cA + (size_t)(t + 2) * kstep; const char* b2 = last ? nB : cB + (size_t)(t + 2) * kstep;
            const char* a3 = a2 + kstep; const char* b3 = b2 + kstep;
            PG8_LDB(B0, 0, 0); PG8_LDB(B1, 0, 1); PG8_SCHED; PG8_LDA(At, 0, 0); PG8_STAGE(PG8_SA(1, 1), a1 + hstepA, voffA);
            PG8_WAIT_V(8); PG8_WAIT_L(0); PG8_BAR; PG8_MMA(0, 0, At, B0); PG8_MMA(0, 1, At, B1); PG8_BAR; PG8_SCHED;
            PG8_LDA(At, 0, 1); PG8_STAGE(PG8_SB(0, 0), b2, voffB); PG8_STAGE(PG8_SB(0, 1), b2 + hstepB, voffB); PG8_STAGE(PG8_SA(0, 0), a2, voffA);
            PG8_WAIT_V(8); PG8_WAIT_L(0); PG8_BAR; PG8_MMA(1, 0, At, B0); PG8_MMA(1, 1, At, B1); PG8_BAR; PG8_SCHED;
            PG8_LDB(B0, 1, 0); PG8_LDB(B1, 1, 1); PG8_SCHED; PG8_LDA(At, 1, 0); PG8_STAGE(PG8_SA(0, 1), a2 + hstepA, voffA);
            PG8_WAIT_V(8); PG8_WAIT_L(0); PG8_BAR; PG8_MMA(0, 0, At, B0); PG8_MMA(0, 1, At, B1); PG8_BAR; PG8_SCHED;
            PG8_LDA(At, 1, 1); PG8_STAGE(PG8_SB(1, 0), b3, voffB); PG8_STAGE(PG8_SB(1, 1), b3 + hstepB, voffB); PG8_STAGE(PG8_SA(1, 0), a3, voffA);
            PG8_WAIT_V(8); PG8_WAIT_L(0); PG8_BAR; PG8_MMA(1, 0, At, B0); PG8_MMA(1, 1, At, B1); PG8_BAR; PG8_SCHED;
        }
        if constexpr (ALIGN_EPI) { if (wr == 0) PG8_BAR; }
        E(acc, cur, wr, wc, fr, fq);
        if (!has_next) break;
#pragma unroll
        for (int a = 0; a < 2; ++a)
#pragma unroll
            for (int b = 0; b < 2; ++b)
#pragma unroll
                for (int m = 0; m < 4; ++m)
#pragma unroll
                    for (int n = 0; n < 2; ++n) acc[a][b][m][n] = (f32x4){0.f, 0.f, 0.f, 0.f};
        cur = nxt; cA = nA; cB = nB; ++ui;
        if constexpr (ALIGN_EPI) { if (wr == 1) PG8_BAR; }
    }
    PG8_WAIT_V(0);
    if constexpr (!ALIGN_EPI) { if (wr == 0) PG8_BAR; }
    PG8_BAR;
#undef PG8_SA
#undef PG8_SB
#undef PG8_STAGE
#undef PG8_LDA
#undef PG8_LDB
#undef PG8_MMA
#undef PG8_WAIT_V
#undef PG8_WAIT_L
#undef PG8_BAR
#undef PG8_SCHED
}
}

namespace {
using pg8::bf16_t; using pg8::bf16x8; using pg8::f32x4; using pg8::u32x4; using pg8::u32x2; using pg8::Unit; using pg8::cvt_pk_bf16;
#define LAS __attribute__((address_space(3)))
constexpr int NWAVES = 8;
constexpr int RING_BYTES = 131072, LDSCTL_OFF = RING_BYTES, MISC_OFF = LDSCTL_OFF + 320, LDS_BYTES = 147456;

__device__ __forceinline__ unsigned f2bf(float f) { unsigned u = __float_as_uint(f); return (u + 0x7fffu + ((u >> 16) & 1u)) >> 16; }
__device__ __forceinline__ float bf2f(unsigned b) { return __uint_as_float(b << 16); }
__device__ __forceinline__ unsigned pk2(float lo, float hi) { return f2bf(lo) | (f2bf(hi) << 16); }
__device__ __forceinline__ float wave_sum(float v) {
#pragma unroll
    for (int o = 1; o < 64; o <<= 1) v += __shfl_xor(v, o);
    return v;
}
__device__ __forceinline__ float hsum(f32x4 v) { return (v.x + v.y) + (v.z + v.w); }
__device__ __forceinline__ float hsq(f32x4 v) { return (v.x * v.x + v.y * v.y) + (v.z * v.z + v.w * v.w); }

__device__ __forceinline__ const float* xrow_ptr(const Params& p, int t) {
    if (t < TP) { const int b = t / PL, q = t - b * PL; return q < NMETA ? p.meta + (size_t)q * D : p.x_prompt + ((size_t)b * SEQ + (q - NMETA)) * D; }
    return p.x_sample + (size_t)(t - TP) * D;
}
__device__ __forceinline__ float* yrow_ptr(const Params& p, int t) {
    if (t < TP) { const int b = t / PL, q = t - b * PL; return q < NMETA ? nullptr : p.out + O_YP + ((size_t)b * SEQ + (q - NMETA)) * D; }
    if (t < T) return p.out + O_YS + (size_t)(t - TP) * D;
    return nullptr;
}

#define XB_TMO      128
#define XB_XCNT(j)  (256  + 64 * (j))
#define XB_XSUB(j)  (1280 + 64 * (j))
#define XB_XGEN(j)  (2304 + 64 * (j))
#define XB_TOP      3328
#define XB_TOPGEN   3392
#define XCD_BAR_WORDS 3456
#define XB_SPIN_CAP (1u << 18)
__device__ __forceinline__ unsigned xb_ld(unsigned* p)              { return __hip_atomic_load(p, __ATOMIC_RELAXED, __HIP_MEMORY_SCOPE_AGENT); }
__device__ __forceinline__ unsigned xb_add(unsigned* p, unsigned v) { return __hip_atomic_fetch_add(p, v, __ATOMIC_RELAXED, __HIP_MEMORY_SCOPE_AGENT); }
__device__ __forceinline__ unsigned xb_xcc_id() { return (unsigned)__builtin_amdgcn_s_getreg((3 << 11) | 20) & 0xFu; }
#define XB_SPIN(cond, bar) do { unsigned _sp = 0; while (cond) { __builtin_amdgcn_s_sleep(1); \
    if ((++_sp & 255u) == 0u) { if (xb_ld(&(bar)[XB_TMO])) break; if (_sp > XB_SPIN_CAP) { atomicAdd(&(bar)[XB_TMO], 1u); break; } } } } while (0)
struct XcdBarrier { unsigned* bar; unsigned x; volatile LAS unsigned* st; int wave; };
__device__ __forceinline__ bool xb_leader(int wave) { return wave == 0 && pg8::lane_id_fresh() == 0; }
__device__ __forceinline__ XcdBarrier xcd_barrier_post(unsigned* bar, volatile LAS unsigned* st, int wave) {
    XcdBarrier b; b.bar = bar; b.x = xb_xcc_id(); b.st = st; b.wave = wave;
    if (xb_leader(wave)) (void)xb_add(&bar[XB_XCNT(b.x)], 1u);
    return b;
}
__device__ __forceinline__ void xcd_barrier_complete(unsigned* bar, unsigned x, unsigned& nloc, unsigned& nx) {
    const unsigned G = gridDim.x * gridDim.y * gridDim.z;
    unsigned sum, cnt, mine, sp = 0u;
    for (;;) {
        sum = 0u; cnt = 0u; mine = 0u;
#pragma unroll
        for (unsigned j = 0; j < 16; ++j) { const unsigned c = xb_ld(&bar[XB_XCNT(j)]); sum += c; cnt += (c > 0u) ? 1u : 0u; mine = (j == x) ? c : mine; }
        if (sum == G) break;
        __builtin_amdgcn_s_sleep(1);
        if ((++sp & 255u) == 0u) { if (xb_ld(&bar[XB_TMO])) break; if (sp > XB_SPIN_CAP) { atomicAdd(&bar[XB_TMO], 1u); break; } }
    }
    nloc = mine > 0u ? mine : 1u; nx = cnt > 0u ? cnt : 1u;
}
__device__ __forceinline__ void xcd_barrier(const XcdBarrier& b) {
    asm volatile("s_waitcnt vmcnt(0)" ::: "memory");
    __syncthreads();
    if (xb_leader(b.wave)) {
        unsigned* bar = b.bar;
        __builtin_amdgcn_s_waitcnt(0);
        unsigned nloc = b.st[0], nx = b.st[1];
        if (nloc == 0u) { xcd_barrier_complete(bar, b.x, nloc, nx); b.st[0] = nloc; b.st[1] = nx; }
        const unsigned old = xb_add(&bar[XB_XSUB(b.x)], 1u);
        const unsigned gen = old / nloc;
        if (old + 1u == (gen + 1u) * nloc) {
            __builtin_amdgcn_fence(__ATOMIC_RELEASE, "agent");
            asm volatile("s_waitcnt vmcnt(0)" ::: "memory");
            const unsigned og = xb_add(&bar[XB_TOP], 1u);
            const unsigned tg = og / nx;
            if (og + 1u == (tg + 1u) * nx) xb_add(&bar[XB_TOPGEN], 1u);
            else XB_SPIN(xb_ld(&bar[XB_TOPGEN]) == tg, bar);
            __builtin_amdgcn_fence(__ATOMIC_ACQUIRE, "agent");
            xb_add(&bar[XB_XGEN(b.x)], 1u);
            asm volatile("s_waitcnt vmcnt(0)" ::: "memory");
        } else {
            XB_SPIN(xb_ld(&bar[XB_XGEN(b.x)]) == gen, bar);
            __builtin_amdgcn_fence(__ATOMIC_ACQUIRE, "agent");
            asm volatile("s_waitcnt vmcnt(0)" ::: "memory");
        }
    }
    __syncthreads();
}

struct EpiIn {
    static constexpr bool PERM = true;
    bf16_t* O; const float* r0;
    __device__ __forceinline__ void operator()(const f32x4 (&acc)[2][2][4][2], const Unit& u, int wr, int wc, int fr, int fq) const {
        const int row0 = u.pm * 256 + wr * 64 + fr, col0 = u.pn * 256 + wc * 32 + 8 * fq;
#pragma unroll
        for (int ai = 0; ai < 2; ++ai)
#pragma unroll
            for (int m = 0; m < 4; ++m) { const int row = row0 + ai * 128 + m * 16; const float sc = r0[row]; bf16_t* rowp = O + (size_t)row * NIN + col0;
#pragma unroll
                for (int bj = 0; bj < 2; ++bj) { const f32x4 v0 = acc[ai][bj][m][0] * sc, v1 = acc[ai][bj][m][1] * sc;
                    u32x4 w; w.x = cvt_pk_bf16(v0[0], v0[1]); w.y = cvt_pk_bf16(v0[2], v0[3]); w.z = cvt_pk_bf16(v1[0], v1[1]); w.w = cvt_pk_bf16(v1[2], v1[3]);
                    *(u32x4*)(rowp + bj * 128) = w; } }
    }
};
struct EpiOut {
    static constexpr bool PERM = true;
    Params p; bf16_t* x1b; float* ssq;
    __device__ __forceinline__ void operator()(const f32x4 (&acc)[2][2][4][2], const Unit& u, int wr, int wc, int fr, int fq) const {
        const int row0 = u.pm * 256 + wr * 64 + fr, col0 = u.pn * 256 + wc * 32 + 8 * fq;
#pragma unroll
        for (int am = 0; am < 4; ++am) { const int ai = am >> 1;
            f32x4 xv[2][2][2];
#pragma unroll
            for (int mm = 0; mm < 2; ++mm) { const int m = (am & 1) * 2 + mm; const int row = row0 + ai * 128 + m * 16; const float* xr = xrow_ptr(p, row < T ? row : 0);
#pragma unroll
                for (int bj = 0; bj < 2; ++bj) { xv[mm][bj][0] = *(const f32x4*)(xr + col0 + bj * 128); xv[mm][bj][1] = *(const f32x4*)(xr + col0 + bj * 128 + 4); } }
#pragma unroll
            for (int mm = 0; mm < 2; ++mm) { const int m = (am & 1) * 2 + mm; const int row = row0 + ai * 128 + m * 16; const float keep = row < T ? 1.f : 0.f; float* yr = yrow_ptr(p, row); float ss = 0.f;
#pragma unroll
                for (int bj = 0; bj < 2; ++bj) { const int col = col0 + bj * 128; const f32x4 a0 = acc[ai][bj][m][0] + xv[mm][bj][0] * keep, a1 = acc[ai][bj][m][1] + xv[mm][bj][1] * keep;
                    if (yr) { *(f32x4*)(yr + col) = a0; *(f32x4*)(yr + col + 4) = a1; }
                    u32x4 w; w.x = cvt_pk_bf16(a0[0], a0[1]); w.y = cvt_pk_bf16(a0[2], a0[3]); w.z = cvt_pk_bf16(a1[0], a1[1]); w.w = cvt_pk_bf16(a1[2], a1[3]);
                    *(u32x4*)(x1b + (size_t)row * D + col) = w; ss += hsq(a0) + hsq(a1); }
                ss += __shfl_xor(ss, 16); ss += __shfl_xor(ss, 32);
                if (fq == 0) atomicAdd(ssq + row, ss); }
        }
    }
};
struct EpiDown {
    static constexpr bool PERM = true;
    Params p; float* ssq;
    __device__ __forceinline__ void operator()(const f32x4 (&acc)[2][2][4][2], const Unit& u, int wr, int wc, int fr, int fq) const {
        const int row0 = u.pm * 256 + wr * 64 + fr, col0 = u.pn * 256 + wc * 32 + 8 * fq;
#pragma unroll
        for (int am = 0; am < 4; ++am) { const int ai = am >> 1;
            f32x4 xv[2][2][2];
#pragma unroll
            for (int mm = 0; mm < 2; ++mm) { const int m = (am & 1) * 2 + mm; const int row = row0 + ai * 128 + m * 16; const float* yr = yrow_ptr(p, row); const float* ld = yr ? yr : p.out;
#pragma unroll
                for (int bj = 0; bj < 2; ++bj) { xv[mm][bj][0] = *(const f32x4*)(ld + col0 + bj * 128); xv[mm][bj][1] = *(const f32x4*)(ld + col0 + bj * 128 + 4); } }
#pragma unroll
            for (int mm = 0; mm < 2; ++mm) { const int m = (am & 1) * 2 + mm; const int row = row0 + ai * 128 + m * 16; float* yr = yrow_ptr(p, row); float ss = 0.f;
#pragma unroll
                for (int bj = 0; bj < 2; ++bj) { const int col = col0 + bj * 128; const f32x4 a0 = acc[ai][bj][m][0] + xv[mm][bj][0], a1 = acc[ai][bj][m][1] + xv[mm][bj][1];
                    if (yr) { *(f32x4*)(yr + col) = a0; *(f32x4*)(yr + col + 4) = a1; } ss += hsq(a0) + hsq(a1); }
                ss += __shfl_xor(ss, 16); ss += __shfl_xor(ss, 32);
                if (fq == 0) ssq[(size_t)row * 16 + u.pn * 4 + wc] = yr ? ss : 0.f; }
        }
    }
};
struct EpiUp {
    static constexpr bool PERM = true;
    const float* cw; const float* cb; const float* state_ffn; float* out; const float* ssq1; bf16_t* act;
    template <int CTRL> static __device__ __forceinline__ float dpp(float x) { return __builtin_bit_cast(float, __builtin_amdgcn_mov_dpp(__builtin_bit_cast(int, x), CTRL, 0xf, 0xf, true)); }
    template <bool SMP>
    __device__ __forceinline__ void half(const f32x4 (&acc)[2][2][4][2], const int ai, const int tb, const int ch0, const int fr) const {
        float r1[4]; bool k1[4], k2[4]; int foff[4]; bool anyf = false;
        float q1[4];
#pragma unroll
        for (int m = 0; m < 4; ++m) { const int t = tb + 16 * m + fr; q1[m] = ssq1[t < 0 ? 0 : t]; }
#pragma unroll
        for (int m = 0; m < 4; ++m) { const int t = tb + 16 * m + fr; const float s = q1[m];
            r1[m] = t >= 0 ? rsqrtf(s * (1.f / D) + EPS) : 0.f;
            int pos, fo = -1; const bool valid = (m > 0 || fr >= 2) && t < T;
            if (!SMP || t < TP) { const int b = t / PL; pos = t - b * PL; if (valid && pos >= PL - 2) fo = (int)O_FP + (b * 2 + (pos - (PL - 2))) * NUP; }
            else { pos = (t - TP) & 3; const int sq = (t - TP) >> 2; if (valid && pos >= 2) fo = (int)O_FS + (sq * 2 + (pos - 2)) * NUP; }
            k1[m] = pos >= 1; k2[m] = pos >= 2; foff[m] = fo; anyf = anyf || (fo >= 0); }
        unsigned ov[4][4];
#pragma unroll
        for (int c4 = 0; c4 < 4; ++c4) { const int n = c4 >> 1, eh = c4 & 1, ch = ch0 + 2 * c4;
            const float2 w0v = *(const float2*)(cw + ch), w1v = *(const float2*)(cw + NUP + ch), w2v = *(const float2*)(cw + 2 * NUP + ch), bv = *(const float2*)(cb + ch);
            const float2 w0g = *(const float2*)(cw + DFF + ch), w1g = *(const float2*)(cw + NUP + DFF + ch), w2g = *(const float2*)(cw + 2 * NUP + DFF + ch), bg = *(const float2*)(cb + DFF + ch);
            float pr1v[2] = {0.f, 0.f}, pr2v[2] = {0.f, 0.f}, pr1g[2] = {0.f, 0.f}, pr2g[2] = {0.f, 0.f};
#pragma unroll
            for (int m = 0; m < 4; ++m) { const int t = tb + 16 * m + fr;
                float s1v[2] = {0.f, 0.f}, s2v[2] = {0.f, 0.f}, s1g[2] = {0.f, 0.f}, s2g[2] = {0.f, 0.f};
                if (SMP) {
                    const bool smp = t >= TP && t < T; const int tt = smp ? t - TP : 0, j = tt & 3, sq = tt >> 2;
                    const float* stA = state_ffn + ((size_t)sq * 2 + (j & 1)) * NUP + ch; const float* stB = state_ffn + ((size_t)sq * 2 + 1) * NUP + ch;
                    const float2 a = *(const float2*)stA, b = *(const float2*)(stA + DFF), c = *(const float2*)stB, d = *(const float2*)(stB + DFF);
                    const bool u2 = smp && j < 2, u1 = smp && j == 0;
                    s2v[0] = u2 ? a.x : 0.f; s2v[1] = u2 ? a.y : 0.f; s2g[0] = u2 ? b.x : 0.f; s2g[1] = u2 ? b.y : 0.f;
                    s1v[0] = u1 ? c.x : 0.f; s1v[1] = u1 ? c.y : 0.f; s1g[0] = u1 ? d.x : 0.f; s1g[1] = u1 ? d.y : 0.f; }
                float av[2];
#pragma unroll
                for (int e = 0; e < 2; ++e) {
                    const float Vv = acc[ai][0][m][n][2 * eh + e] * r1[m], Vg = acc[ai][1][m][n][2 * eh + e] * r1[m];
                    const float c1v = dpp<0x121>(Vv), c2v = dpp<0x122>(Vv), c1g = dpp<0x121>(Vg), c2g = dpp<0x122>(Vg);
                    float p1v = fr >= 1 ? c1v : pr1v[e], p2v = fr >= 2 ? c2v : pr2v[e], p1g = fr >= 1 ? c1g : pr1g[e], p2g = fr >= 2 ? c2g : pr2g[e];
                    pr1v[e] = c1v; pr2v[e] = c2v; pr1g[e] = c1g; pr2g[e] = c2g;
                    p1v = k1[m] ? p1v : s1v[e]; p1g = k1[m] ? p1g : s1g[e]; p2v = k2[m] ? p2v : s2v[e]; p2g = k2[m] ? p2g : s2g[e];
                    const float wv0 = e ? w0v.y : w0v.x, wv1 = e ? w1v.y : w1v.x, wv2 = e ? w2v.y : w2v.x, bvv = e ? bv.y : bv.x;
                    const float wg0 = e ? w0g.y : w0g.x, wg1 = e ? w1g.y : w1g.x, wg2 = e ? w2g.y : w2g.x, bgg = e ? bg.y : bg.x;
                    const float val = wv0 * p2v + wv1 * p1v + wv2 * Vv + bvv, gate = wg0 * p2g + wg1 * p1g + wg2 * Vg + bgg;
                    av[e] = val * gate * __builtin_amdgcn_rcpf(1.f + __expf(-gate)); }
                ov[m][c4] = cvt_pk_bf16(av[0], av[1]);
            } }
#pragma unroll
        for (int m = 0; m < 4; ++m) { const int t = tb + 16 * m + fr; const bool valid = (m > 0 || fr >= 2) && t < T;
            if (valid) { u32x4 w; w.x = ov[m][0]; w.y = ov[m][1]; w.z = ov[m][2]; w.w = ov[m][3]; *(u32x4*)(act + (size_t)t * DFF + ch0) = w; } }
        if (__any(anyf)) {
#pragma unroll
            for (int m = 0; m < 4; ++m) if (foff[m] >= 0) { float* o = out + foff[m] + ch0;
#pragma unroll
                for (int n = 0; n < 2; ++n) { *(f32x4*)(o + 4 * n) = acc[ai][0][m][n] * r1[m]; *(f32x4*)(o + DFF + 4 * n) = acc[ai][1][m][n] * r1[m]; } }
        }
    }
    __device__ __forceinline__ void operator()(const f32x4 (&acc)[2][2][4][2], const Unit& u, int wr, int wc, int fr, int fq) const {
        const int ch0 = u.pn * 128 + wc * 32 + 8 * fq;
#pragma unroll
        for (int ai = 0; ai < 2; ++ai) {
            const int tb = ETILE * u.pm - 2 + EBLK * (2 * ai + wr);
            if (tb + 63 >= TP) half<true>(acc, ai, tb, ch0, fr); else half<false>(acc, ai, tb, ch0, fr);
        }
    }
};

__device__ __forceinline__ int wup_src_col(int n) { const int pn = n >> 8, w = n & 255, bj = w >> 7, c = w & 127; return bj * DFF + 128 * pn + c; }
template <bool MAP>
__device__ __forceinline__ void p0_transpose_item(const float* W, int K, int N, int NP, bf16_t* WT, const float* gain, LAS float* scr, int item, int lane) {
    const int nblk = NP / 32, kb = item / nblk, nb = item % nblk, k0 = 64 * kb, n0 = 32 * nb, s0 = MAP ? wup_src_col(n0) : n0;
    float v[32];
#pragma unroll
    for (int i = 0; i < 32; ++i) { const int kk = 2 * i + (lane >> 5); v[i] = W[(size_t)(k0 + kk) * N + s0 + (lane & 31)]; }
    const int c = lane & 7;
    f32x4 g0 = (f32x4){1.f, 1.f, 1.f, 1.f}, g1 = g0;
    if (gain) { g0 = *(const f32x4*)(gain + k0 + 8 * c); g1 = *(const f32x4*)(gain + k0 + 8 * c + 4); }
#pragma unroll
    for (int i = 0; i < 32; ++i) { const int kk = 2 * i + (lane >> 5); scr[kk * 33 + (lane & 31)] = v[i]; }
    asm volatile("s_waitcnt lgkmcnt(0)" ::: "memory");
#pragma unroll
    for (int j = 0; j < 4; ++j) { const int n = (lane >> 3) + 8 * j; const LAS float* s = scr + (8 * c) * 33 + n;
        u32x4 o; o.x = pk2(s[0 * 33] * g0.x, s[1 * 33] * g0.y); o.y = pk2(s[2 * 33] * g0.z, s[3 * 33] * g0.w); o.z = pk2(s[4 * 33] * g1.x, s[5 * 33] * g1.y); o.w = pk2(s[6 * 33] * g1.z, s[7 * 33] * g1.w);
        *(u32x4*)(WT + (size_t)(n0 + n) * K + k0 + 8 * c) = o; }
    asm volatile("s_waitcnt lgkmcnt(0)" ::: "memory");
}
__device__ __forceinline__ void p0_prologue(const Params& p, LAS unsigned char* lds, int gw, int NGW, int wave) {
    const int lane = pg8::lane_id_fresh();
    LAS float* scr = (LAS float*)(lds + wave * 16384);
    bf16_t* win = (bf16_t*)(p.ws + WS_WIN); bf16_t* wout = (bf16_t*)(p.ws + WS_WOUT); bf16_t* wup = (bf16_t*)(p.ws + WS_WUP); bf16_t* wdown = (bf16_t*)(p.ws + WS_WDOWN); bf16_t* wpool = (bf16_t*)(p.ws + WS_WPOOL);
    constexpr int I_IN = (D / 64) * (NIN / 32), I_OUT = (D / 64) * (D / 32), I_UP = (D / 64) * (NUP / 32), I_DN = (DFF / 64) * (D / 32), I_PL = 4 * (128 / 64) * (128 / 32);
    constexpr int NITEMS = I_IN + I_OUT + I_UP + I_DN + I_PL;
    bf16_t* xb = (bf16_t*)(p.ws + WS_XB); float* r0 = (float*)(p.ws + WS_R0); bf16_t* mix = (bf16_t*)(p.ws + WS_MIX); bf16_t* x1b = (bf16_t*)(p.ws + WS_X1B);
    for (int tq = gw; tq < T / 4; tq += NGW) {
        f32x4 v[4][4];
#pragma unroll
        for (int r = 0; r < 4; ++r) { const f32x4* xr = (const f32x4*)xrow_ptr(p, 4 * tq + r) + lane;
#pragma unroll
            for (int j = 0; j < 4; ++j) v[r][j] = xr[64 * j]; }
#pragma unroll
        for (int r = 0; r < 4; ++r) { const int t = 4 * tq + r; float s = 0.f;
#pragma unroll
            for (int j = 0; j < 4; ++j) s += hsq(v[r][j]);
            s = wave_sum(s);
            if (lane == 0) r0[t] = rsqrtf(s * (1.f / D) + EPS);
            unsigned long long* o8 = (unsigned long long*)(xb + (size_t)t * D) + lane;
#pragma unroll
            for (int j = 0; j < 4; ++j) o8[64 * j] = (unsigned long long)pk2(v[r][j].x, v[r][j].y) | ((unsigned long long)pk2(v[r][j].z, v[r][j].w) << 32); }
    }
    { float* ssq1 = (float*)(p.ws + WS_SSQ1); for (int t = gw * 64 + lane; t < MPAD; t += NGW * 64) ssq1[t] = 0.f; }
    for (int t = T + gw; t < MPAD + X1B_PADROWS; t += NGW) {
        if (t >= MPAD) { unsigned long long* o8 = (unsigned long long*)(x1b + (size_t)(t - MPAD) * D) + lane; for (int j = 0; j < 4; ++j) o8[64 * j] = 0ull; continue; }
        unsigned long long* o8 = (unsigned long long*)(xb + (size_t)t * D) + lane; unsigned long long* m8 = (unsigned long long*)(mix + (size_t)t * D) + lane;
        for (int j = 0; j < 4; ++j) { o8[64 * j] = 0ull; m8[64 * j] = 0ull; } if (lane == 0) r0[t] = 0.f;
    }
    for (int it = gw; it < NITEMS; it += NGW) {
        int r = it;
        if (r < I_IN) { p0_transpose_item<false>(p.w_in, D, NIN, NIN, win, p.norm_mix, scr, r, lane); continue; } r -= I_IN;
        if (r < I_UP) { p0_transpose_item<true>(p.w_up, D, NUP, NUP, wup, p.norm_ffn, scr, r, lane); continue; } r -= I_UP;
        if (r < I_DN) { p0_transpose_item<false>(p.w_down, DFF, D, D, wdown, nullptr, scr, r, lane); continue; } r -= I_DN;
        if (r < I_OUT) { p0_transpose_item<false>(p.w_out, D, D, D, wout, nullptr, scr, r, lane); continue; } r -= I_OUT;
        { const int g = r >> 3; p0_transpose_item<false>(p.w_pool + (size_t)g * 16384, 128, 128, 128, wpool + (size_t)g * 16384, nullptr, scr, r & 7, lane); }
    }
}

constexpr int MIX_ROWB = 272;
template <int W>
__device__ __forceinline__ void pool_prompt_tile(const Params& p, const bf16_t* proj, LAS unsigned char* scr, int t0, int b, int p0, int g, int lane) {
    const int cu = 128 * g + 2 * lane;
    unsigned uw[31];
#pragma unroll
    for (int dr = 0; dr < 31; ++dr) { const int tr = t0 - 15 + dr; uw[dr] = *(const unsigned*)(proj + (size_t)(tr < 0 ? 0 : tr) * NIN + cu); }
    float ua[31], ub[31];
#pragma unroll
    for (int dr = 0; dr < 31; ++dr) { const unsigned w = (p0 - 15 + dr >= 0) ? uw[dr] : 0u; ua[dr] = bf2f(w & 0xffffu); ub[dr] = bf2f(w >> 16); }
    float ca[32], cb2[32]; ca[0] = 0.f; cb2[0] = 0.f;
#pragma unroll
    for (int dr = 0; dr < 31; ++dr) { ca[dr + 1] = ca[dr] + ua[dr]; cb2[dr + 1] = cb2[dr] + ub[dr]; }
#pragma unroll
    for (int i = 0; i < 16; ++i) {
        const int pos = p0 + i; const float inv = 1.f / (float)(pos + 1 < W ? pos + 1 : W);
        const float da = (ca[16 + i] - ca[16 + i - W]) * inv - ua[15 + i], db = (cb2[16 + i] - cb2[16 + i - W]) * inv - ub[15 + i];
        *(LAS unsigned*)(scr + i * MIX_ROWB + 4 * lane) = pk2(da, db);
        if (pos >= PL - PBUF) { float2 o; o.x = ua[15 + i]; o.y = ub[15 + i]; *(float2*)(p.out + O_PP + ((size_t)b * PBUF + (pos - (PL - PBUF))) * POOLW + cu) = o; }
    }
}
template <int W>
__device__ __forceinline__ void pool_sample_tile(const Params& p, const bf16_t* proj, LAS unsigned char* scr, int t0, int s0, int g, int lane) {
    const int cu = 128 * g + 2 * lane;
#pragma unroll
    for (int q = 0; q < 4; ++q) { const int sq = s0 + q;
        float2 ex[19];
#pragma unroll
        for (int r = 0; r < 15; ++r) ex[r] = *(const float2*)(p.state_pool + ((size_t)sq * PBUF + r) * POOLW + cu);
#pragma unroll
        for (int j = 0; j < 4; ++j) { const unsigned w = *(const unsigned*)(proj + (size_t)(t0 + 4 * q + j) * NIN + cu); ex[15 + j].x = bf2f(w & 0xffffu); ex[15 + j].y = bf2f(w >> 16); }
        float ca[20], cb2[20]; ca[0] = 0.f; cb2[0] = 0.f;
#pragma unroll
        for (int r = 0; r < 19; ++r) { ca[r + 1] = ca[r] + ex[r].x; cb2[r + 1] = cb2[r] + ex[r].y; }
#pragma unroll
        for (int j = 0; j < 4; ++j) { const float inv = 1.f / (float)W;
            const float da = (ca[16 + j] - ca[16 + j - W]) * inv - ex[15 + j].x, db = (cb2[16 + j] - cb2[16 + j - W]) * inv - ex[15 + j].y;
            *(LAS unsigned*)(scr + (4 * q + j) * MIX_ROWB + 4 * lane) = pk2(da, db); }
#pragma unroll
        for (int r = 0; r < PBUF; ++r) *(float2*)(p.out + O_PS + ((size_t)sq * PBUF + r) * POOLW + cu) = ex[r + DS];
    }
}
__device__ __forceinline__ void mixer_phase(const Params& p, LAS unsigned char* lds, int gw, int NGW, int wave) {
    const int lane = pg8::lane_id_fresh();
    LAS unsigned char* scr = lds + wave * 8192;
    const bf16_t* proj = (const bf16_t*)(p.ws + WS_PROJ); bf16_t* mix = (bf16_t*)(p.ws + WS_MIX); const bf16_t* wpool = (const bf16_t*)(p.ws + WS_WPOOL);
    const int fr = lane & 15, fq = lane >> 4;
    constexpr int NITEM = (T / 16) * 4;
    for (int it = gw; it < NITEM; it += NGW) {
        const int tt = it >> 2, qd = it & 3, t0 = 16 * tt, g = qd, cc = 128 * qd + 2 * lane;
        const float2 w0 = *(const float2*)(p.conv_w + cc), w1 = *(const float2*)(p.conv_w + CONVW + cc), w2 = *(const float2*)(p.conv_w + 2 * CONVW + cc);
        if (t0 < TP) {
            const int b = t0 / PL, p0 = t0 - b * PL;
            unsigned zc[18], zv[18], zg[16];
#pragma unroll
            for (int dr = 0; dr < 18; ++dr) { const int tr = t0 - 2 + dr; const bf16_t* row = proj + (size_t)(tr < 0 ? 0 : tr) * NIN; zc[dr] = *(const unsigned*)(row + 1024 + cc); zv[dr] = *(const unsigned*)(row + 1536 + cc); }
#pragma unroll
            for (int i = 0; i < 16; ++i) zg[i] = *(const unsigned*)(proj + (size_t)(t0 + i) * NIN + 512 + cc);
            if (g == 0) pool_prompt_tile<2>(p, proj, scr, t0, b, p0, g, lane);
            else if (g == 1) pool_prompt_tile<4>(p, proj, scr, t0, b, p0, g, lane);
            else if (g == 2) pool_prompt_tile<8>(p, proj, scr, t0, b, p0, g, lane);
            else pool_prompt_tile<16>(p, proj, scr, t0, b, p0, g, lane);
            float za[18], zb[18];
#pragma unroll
            for (int dr = 0; dr < 18; ++dr) { const bool ok = p0 - 2 + dr >= 0; const unsigned wc_ = ok ? zc[dr] : 0u, wv = zv[dr];
                za[dr] = bf2f(wc_ & 0xffffu) * bf2f(wv & 0xffffu); zb[dr] = bf2f(wc_ >> 16) * bf2f(wv >> 16); }
#pragma unroll
            for (int i = 0; i < 16; ++i) { const unsigned wg = zg[i];
                const float ca_ = w0.x * za[i] + w1.x * za[i + 1] + w2.x * za[i + 2], cb_ = w0.y * zb[i] + w1.y * zb[i + 1] + w2.y * zb[i + 2];
                *(unsigned*)(mix + (size_t)(t0 + i) * D + 512 + cc) = pk2(bf2f(wg & 0xffffu) * ca_, bf2f(wg >> 16) * cb_);
                const int pos = p0 + i; if (pos >= PL - 2) { float2 o; o.x = za[i + 2]; o.y = zb[i + 2]; *(float2*)(p.out + O_CP + ((size_t)b * 2 + (pos - (PL - 2))) * CONVW + cc) = o; } }
        } else {
            const int s0 = (t0 - TP) >> 2;
            if (g == 0) pool_sample_tile<2>(p, proj, scr, t0, s0, g, lane);
            else if (g == 1) pool_sample_tile<4>(p, proj, scr, t0, s0, g, lane);
            else if (g == 2) pool_sample_tile<8>(p, proj, scr, t0, s0, g, lane);
            else pool_sample_tile<16>(p, proj, scr, t0, s0, g, lane);
#pragma unroll
            for (int q = 0; q < 4; ++q) { const int sq = s0 + q;
                float za[6], zb[6]; unsigned zg[4];
#pragma unroll
                for (int r = 0; r < 2; ++r) { const float2 s = *(const float2*)(p.state_conv + ((size_t)sq * 2 + r) * CONVW + cc); za[r] = s.x; zb[r] = s.y; }
#pragma unroll
                for (int j = 0; j < 4; ++j) { const bf16_t* row = proj + (size_t)(t0 + 4 * q + j) * NIN; const unsigned wc_ = *(const unsigned*)(row + 1024 + cc), wv = *(const unsigned*)(row + 1536 + cc);
                    za[2 + j] = bf2f(wc_ & 0xffffu) * bf2f(wv & 0xffffu); zb[2 + j] = bf2f(wc_ >> 16) * bf2f(wv >> 16); zg[j] = *(const unsigned*)(row + 512 + cc); }
#pragma unroll
                for (int j = 0; j < 4; ++j) { const float ca_ = w0.x * za[j] + w1.x * za[j + 1] + w2.x * za[j + 2], cb_ = w0.y * zb[j] + w1.y * zb[j + 1] + w2.y * zb[j + 2];
                    *(unsigned*)(mix + (size_t)(t0 + 4 * q + j) * D + 512 + cc) = pk2(bf2f(zg[j] & 0xffffu) * ca_, bf2f(zg[j] >> 16) * cb_);
                    if (j >= DS - 2) { float2 o; o.x = za[2 + j]; o.y = zb[2 + j]; *(float2*)(p.out + O_CS + ((size_t)sq * 2 + (j - (DS - 2))) * CONVW + cc) = o; } }
            }
        }
        asm volatile("s_waitcnt lgkmcnt(0)" ::: "memory");
        bf16x8 af[4];
#pragma unroll
        for (int s = 0; s < 4; ++s) af[s] = *(const LAS bf16x8*)(scr + fr * MIX_ROWB + (32 * s + 8 * fq) * 2);
#pragma unroll
        for (int nh = 0; nh < 2; ++nh) {
            bf16x8 bfr[4][4]; f32x4 sc[4];
#pragma unroll
            for (int nb = 0; nb < 4; ++nb) { sc[nb] = *(const f32x4*)(p.pool_scale + 128 * g + 16 * (4 * nh + nb) + 4 * fq);
#pragma unroll
                for (int s = 0; s < 4; ++s) bfr[nb][s] = *(const bf16x8*)(wpool + ((size_t)(g * 128 + 16 * (4 * nh + nb) + fr)) * 128 + 32 * s + 8 * fq); }
#pragma unroll
            for (int nb = 0; nb < 4; ++nb) { f32x4 a = (f32x4){0.f, 0.f, 0.f, 0.f};
#pragma unroll
                for (int s = 0; s < 4; ++s) a = __builtin_amdgcn_mfma_f32_16x16x32_bf16(bfr[nb][s], af[s], a, 0, 0, 0);
                const int col = 128 * g + 16 * (4 * nh + nb) + 4 * fq; a = a * sc[nb];
                u32x2 o; o.x = cvt_pk_bf16(a[0], a[1]); o.y = cvt_pk_bf16(a[2], a[3]); *(u32x2*)(mix + (size_t)(t0 + fr) * D + col) = o; } }
        asm volatile("s_waitcnt lgkmcnt(0)" ::: "memory");
    }
}

__device__ __forceinline__ void final_phase(const Params& p, int gw, int NGW) {
    const int lane = pg8::lane_id_fresh();
    const float* ssq2 = (const float*)(p.ws + WS_SSQ2);
    f32x4 gv[4];
#pragma unroll
    for (int j = 0; j < 4; ++j) gv[j] = *((const f32x4*)p.norm_final + lane + 64 * j);
    for (int tq = gw; tq < T / 4; tq += NGW) {
        float* y0 = yrow_ptr(p, 4 * tq); if (!y0) continue;
        f32x4 v[4][4], q4[4][4];
#pragma unroll
        for (int r = 0; r < 4; ++r) { const f32x4* yr = (const f32x4*)yrow_ptr(p, 4 * tq + r) + lane; const f32x4* q = (const f32x4*)(ssq2 + (size_t)(4 * tq + r) * 16);
#pragma unroll
            for (int j = 0; j < 4; ++j) { v[r][j] = yr[64 * j]; q4[r][j] = q[j]; } }
#pragma unroll
        for (int r = 0; r < 4; ++r) { const float s = (hsum(q4[r][0]) + hsum(q4[r][1])) + (hsum(q4[r][2]) + hsum(q4[r][3])); const float rr = rsqrtf(s * (1.f / D) + EPS);
            f32x4* yr = (f32x4*)yrow_ptr(p, 4 * tq + r) + lane;
#pragma unroll
            for (int j = 0; j < 4; ++j) yr[64 * j] = v[r][j] * rr * gv[j]; }
    }
}

struct Args { Params p; };
__global__ void __launch_bounds__(NWAVES * 64, 2) fwd_megakernel(Args args) {
    extern __shared__ __attribute__((aligned(16))) unsigned char lds_raw[];
    LAS unsigned char* lds = (LAS unsigned char*)lds_raw;
    const Params& p = args.p;
    const int wave = __builtin_amdgcn_readfirstlane((int)threadIdx.x >> 6), tid = wave * 64 + pg8::lane_id_fresh();
    const int G = gridDim.x, bx = blockIdx.x, vcu = (G % 8 == 0) ? (bx % 8) * (G / 8) + bx / 8 : bx;
    const int gw = vcu * NWAVES + wave, NGW = G * NWAVES;
    unsigned* ctl = (unsigned*)(p.ws + WS_CTL);
    for (int u = tid; u < (LDS_BYTES - LDSCTL_OFF) / 4; u += NWAVES * 64) ((LAS unsigned*)(lds + LDSCTL_OFF))[u] = 0u;
    __syncthreads();
    const XcdBarrier bar = xcd_barrier_post(ctl + CW_BAR, (volatile LAS unsigned*)(lds + MISC_OFF) + 8, wave);

#ifndef REP_P0
#define REP_P0 1
#define REP_P1 1
#define REP_P2 1
#define REP_P3 1
#define REP_P4 1
#endif
    for (int rep = 0; rep < REP_P0; ++rep) { p0_prologue(p, lds, gw, NGW, wave); xcd_barrier(bar); }
    for (int rep = 0; rep < REP_P1; ++rep) { pg8::Gemm g{(const bf16_t*)(p.ws + WS_XB), (const bf16_t*)(p.ws + WS_WIN), D, 64}; pg8::StaticOrder S; S.init(NM, NIN / 256, G, bx);
      EpiIn E{(bf16_t*)(p.ws + WS_PROJ), (const float*)(p.ws + WS_R0)};
      pg8::gemm_phase<EpiIn, true>(lds, g, S, E, wave); xcd_barrier(bar); }
    for (int rep = 0; rep < REP_P2; ++rep) { mixer_phase(p, lds, gw, NGW, wave); xcd_barrier(bar); }
    for (int rep = 0; rep < REP_P3; ++rep) { pg8::Gemm g{(const bf16_t*)(p.ws + WS_MIX), (const bf16_t*)(p.ws + WS_WOUT), D, 64}; pg8::StaticOrder S; S.init(NM, D / 256, G, bx);
      EpiOut E{p, (bf16_t*)(p.ws + WS_X1B) + (size_t)X1B_PADROWS * D, (float*)(p.ws + WS_SSQ1)};
      pg8::gemm_phase<EpiOut, true>(lds, g, S, E, wave); xcd_barrier(bar); }
    for (int rep = 0; rep < REP_P4; ++rep) { pg8::Gemm g{(const bf16_t*)(p.ws + WS_X1B) + (size_t)(X1B_PADROWS - 2) * D, (const bf16_t*)(p.ws + WS_WUP), D, EBLK}; pg8::StaticOrder S; S.init(NME, NUP / 256, G, bx);
      EpiUp E{p.ffn_conv_w, p.ffn_conv_b, p.state_ffn, p.out, (const float*)(p.ws + WS_SSQ1), (bf16_t*)(p.ws + WS_ACT)};
      pg8::gemm_phase<EpiUp, true>(lds, g, S, E, wave); xcd_barrier(bar); }
    { pg8::Gemm g{(const bf16_t*)(p.ws + WS_ACT), (const bf16_t*)(p.ws + WS_WDOWN), DFF, 64}; pg8::StaticOrder S; S.init(NM, D / 256, G, bx);
      EpiDown E{p, (float*)(p.ws + WS_SSQ2)};
      pg8::gemm_phase<EpiDown, true>(lds, g, S, E, wave); }
    xcd_barrier(bar);
    final_phase(p, gw, NGW);
}
}

extern "C" void kernel_launch(void* const* d_in, const int* in_sizes, int n_in, void* d_out, int out_size, void* d_ws, size_t ws_size, hipStream_t stream) {
    static int grid = 0;
    if (grid == 0) {
        if (n_in != 18 || ws_size < WS_END) { fprintf(stderr, "kernel_launch: unexpected inputs (n_in %d, ws %zu)\n", n_in, ws_size); grid = -1; return; }
        int dev = 0, cus = 0, per_cu = 0;
        if (hipGetDevice(&dev) != hipSuccess || hipDeviceGetAttribute(&cus, hipDeviceAttributeMultiprocessorCount, dev) != hipSuccess) { grid = -1; return; }
        if (hipFuncSetAttribute((const void*)fwd_megakernel, hipFuncAttributeMaxDynamicSharedMemorySize, LDS_BYTES) != hipSuccess) { fprintf(stderr, "kernel_launch: hipFuncSetAttribute failed\n"); grid = -1; return; }
        if (hipOccupancyMaxActiveBlocksPerMultiprocessor(&per_cu, (const void*)fwd_megakernel, NWAVES * 64, LDS_BYTES) != hipSuccess || per_cu < 1)
            fprintf(stderr, "kernel_launch: note: occupancy query reports %d workgroups per CU\n", per_cu);
        (void)hipGetLastError();
        grid = cus;
    }
    if (grid < 0) return;
    (void)hipMemsetAsync((char*)d_ws + WS_CTL, 0, CTL_ZERO_BYTES, stream);
    Args a{};
    Params& p = a.p;
    p.x_prompt = (const float*)d_in[0]; p.x_sample = (const float*)d_in[1]; p.state_pool = (const float*)d_in[2]; p.state_conv = (const float*)d_in[3]; p.state_ffn = (const float*)d_in[4];
    p.meta = (const float*)d_in[5]; p.norm_mix = (const float*)d_in[6]; p.w_in = (const float*)d_in[7]; p.w_pool = (const float*)d_in[8]; p.pool_scale = (const float*)d_in[9];
    p.conv_w = (const float*)d_in[10]; p.w_out = (const float*)d_in[11]; p.norm_ffn = (const float*)d_in[12]; p.w_up = (const float*)d_in[13]; p.ffn_conv_w = (const float*)d_in[14];
    p.ffn_conv_b = (const float*)d_in[15]; p.w_down = (const float*)d_in[16]; p.norm_final = (const float*)d_in[17];
    p.out = (float*)d_out; p.ws = (unsigned char*)d_ws;
    hipLaunchKernelGGL(fwd_megakernel, dim3(grid), dim3(NWAVES * 64), LDS_BYTES, stream, a);
    const hipError_t le = hipPeekAtLastError();
    if (le != hipSuccess) fprintf(stderr, "kernel_launch: launch failed: %s\n", hipGetErrorName(le));
}
```

```cpp
#include <hip/hip_runtime.h>
#include <cstdio>
#include <cstdint>

namespace {
constexpr int D = 1024, NB = 8, SEQ = 2048, NMETA = 16, PL = SEQ + NMETA, TP = NB * PL, DB = 128, DS = 4, TS = DB * DS, T = TP + TS;
constexpr int MPAD = 17152;
constexpr int POOLW = 512, CONVW = 512, NIN = 2048, DFF = 2816, NUP = 5632, PBUF = 15;
constexpr float EPS = 1e-6f;
constexpr int NM = MPAD / 256;
constexpr int EBLK = 62, ETILE = 4 * EBLK;
constexpr int NME = (T + ETILE - 1) / ETILE;
constexpr size_t O_YP = 0, O_YS = (size_t)NB * SEQ * D, O_PP = O_YS + (size_t)TS * D, O_CP = O_PP + (size_t)NB * PBUF * POOLW,
                 O_FP = O_CP + (size_t)NB * 2 * CONVW, O_PS = O_FP + (size_t)NB * 2 * NUP, O_CS = O_PS + (size_t)DB * PBUF * POOLW,
                 O_FS = O_CS + (size_t)DB * 2 * CONVW;
constexpr size_t MiB = 1u << 20;
constexpr size_t WS_CTL = 0, CTL_ZERO_BYTES = 64 * 1024;
constexpr size_t WS_R0 = 256 * 1024;
constexpr size_t WS_SSQ1 = 2 * MiB, WS_SSQ2 = 4 * MiB;
constexpr size_t WS_WIN = 6 * MiB, WS_WOUT = 10 * MiB, WS_WUP = 12 * MiB, WS_WDOWN = 23 * MiB, WS_WPOOL = 29 * MiB;
constexpr size_t WS_MIX = 30 * MiB, WS_X1B = 64 * MiB, WS_XB = 98 * MiB, WS_PROJ = 132 * MiB, WS_ACT = 98 * MiB, WS_UPS = 200 * MiB, WS_END = 212 * MiB;
constexpr int X1B_PADROWS = 16;
static_assert(WS_MIX + (size_t)MPAD * D * 2 <= WS_X1B && WS_X1B + (size_t)(MPAD + X1B_PADROWS) * D * 2 <= WS_XB && WS_XB + (size_t)MPAD * D * 2 <= WS_PROJ &&
              WS_PROJ + (size_t)MPAD * NIN * 2 <= WS_UPS && WS_UPS + (size_t)TS * NUP * 4 <= WS_END && WS_ACT + (size_t)MPAD * DFF * 2 <= WS_UPS && WS_WUP + (size_t)NUP * D * 2 <= WS_WDOWN && WS_WDOWN + (size_t)D * DFF * 2 <= WS_WPOOL, "d_ws map");
constexpr int CW_BAR = 1024;

struct Params {
    const float *x_prompt, *x_sample, *state_pool, *state_conv, *state_ffn, *meta, *norm_mix, *w_in, *w_pool, *pool_scale, *conv_w, *w_out,
        *norm_ffn, *w_up, *ffn_conv_w, *ffn_conv_b, *w_down, *norm_final;
    float* out; unsigned char* ws;
};
}

namespace pg8 {
#define PG8_LAS __attribute__((address_space(3)))
typedef unsigned short bf16_t;
typedef short bf16x8 __attribute__((ext_vector_type(8)));
typedef float f32x4 __attribute__((ext_vector_type(4)));
typedef unsigned u32x4 __attribute__((ext_vector_type(4)));
typedef unsigned u32x2 __attribute__((ext_vector_type(2)));
constexpr int BM = 256, BK = 64, HALF = 128, HTB = HALF * BK * 2  , STAGE_BYTES = 8 * HTB, NXCD = 8, WGM = 8;

__host__ __device__ __forceinline__ int lds_byte(int r, int c) { const int st = (r >> 4) * 2 + (c >> 5), rr = r & 15, cc = c & 31, ob = rr * 64 + cc * 2; return st * 1024 + (ob ^ (((ob >> 9) & 1) << 5)); }
__host__ __device__ __forceinline__ void stage_rc(int b, int& R, int& C) { const int st = b / 1024, sb = b % 1024, swz = sb ^ (((sb >> 9) & 1) << 5); R = (st >> 1) * 16 + swz / 64; C = (st & 1) * 32 + (swz % 64) / 2; }
__host__ __device__ __forceinline__ int perm32(int rho) { const int n = rho >> 4, i = rho & 15; return 8 * (i >> 2) + 4 * n + (i & 3); }

struct Unit { int pm, pn; };
struct Gemm { const bf16_t* A; const bf16_t* Bt; int K; int ablk; };

struct StaticOrder {
    int nM, nN, nwg, G, c;
    __host__ __device__ void init(int nM_, int nN_, int G_, int c_) { nM = nM_; nN = nN_; nwg = nM * nN; G = G_; c = c_; }
    __host__ __device__ bool next(int i, Unit& u) const {
        const long L = (long)i * G + c; if (L >= nwg) return false;
        int wgid = (int)L; { const int q = nwg / NXCD, r = nwg % NXCD, xcd = wgid % NXCD, off = wgid / NXCD; wgid = (xcd < r ? xcd * (q + 1) : r * (q + 1) + (xcd - r) * q) + off; }
        const int nig = WGM * nN, gid = wgid / nig, fm = gid * WGM, gsz = (nM - fm) < WGM ? (nM - fm) : WGM;
        u.pm = fm + ((wgid % nig) % gsz); u.pn = (wgid % nig) / gsz; return true;
    }
};

__device__ __forceinline__ unsigned cvt_pk_bf16(float lo, float hi) { unsigned r; asm volatile("v_cvt_pk_bf16_f32 %0, %1, %2" : "=v"(r) : "v"(lo), "v"(hi)); return r; }
__device__ __forceinline__ int lane_id_fresh() { int l; asm volatile("v_mbcnt_lo_u32_b32 %0, -1, 0\n\tv_mbcnt_hi_u32_b32 %0, -1, %0" : "=v"(l)); return l; }

template <class Epi, bool ALIGN_EPI>
__device__ __forceinline__ void gemm_phase(PG8_LAS unsigned char* lds, const Gemm g, const StaticOrder& S, const Epi& E, const int wave_id) {
    const int wid = wave_id, lane = lane_id_fresh(), tid = wid * 64 + lane, wr = wid >> 2, wc = wid & 3, fr = lane & 15, fq = lane >> 4;
    const int K = g.K, nt = K / BK;
    unsigned voffA[2], voffB[2];
#pragma unroll
    for (int i = 0; i < 2; ++i) { int R, C; stage_rc(tid * 16 + i * 8192, R, C); const int Rb = Epi::PERM ? ((R & ~31) + perm32(R & 31)) : R; const int Ra = (R >> 6) * g.ablk + (R & 63);
        voffA[i] = (unsigned)(Ra * K + C) * 2u; voffB[i] = (unsigned)(Rb * K + C) * 2u; }
    const size_t kstep = (size_t)(BK * 2);
    const size_t hstepB = (size_t)HALF * K * 2, tstepB = 2 * hstepB;
    const size_t hstepA = (size_t)2 * g.ablk * K * 2, tstepA = 2 * hstepA;
    const unsigned ldsw = (unsigned)wid * 1024u;
    const int aoff = lds_byte(wr * 64 + fr, fq * 8), boff = lds_byte(wc * 32 + fr, fq * 8);
#define PG8_SA(b, h) (((b) * 2 + (h)) * HTB)
#define PG8_SB(b, h) ((4 + (b) * 2 + (h)) * HTB)
#define PG8_STAGE(bufoff, gbase, voff) do { _Pragma("unroll") for (int _i = 0; _i < 2; ++_i) \
        __builtin_amdgcn_global_load_lds((const unsigned*)((const char*)(gbase) + (voff)[_i]), (PG8_LAS unsigned*)(lds + (bufoff) + ldsw + _i * 8192), 16, 0, 0); } while (0)
#define PG8_LDA(dst, b, h) do { _Pragma("unroll") for (int m = 0; m < 4; ++m) _Pragma("unroll") for (int k = 0; k < 2; ++k) dst[m][k] = *(const PG8_LAS bf16x8*)(lds + PG8_SA(b, h) + aoff + m * 2048 + k * 1024); } while (0)
#define PG8_LDB(dst, b, h) do { _Pragma("unroll") for (int n = 0; n < 2; ++n) _Pragma("unroll") for (int k = 0; k < 2; ++k) dst[n][k] = *(const PG8_LAS bf16x8*)(lds + PG8_SB(b, h) + boff + n * 2048 + k * 1024); } while (0)
#define PG8_MMA(ai, bj, At, Bt) do { __builtin_amdgcn_s_setprio(1); _Pragma("unroll") for (int m = 0; m < 4; ++m) _Pragma("unroll") for (int n = 0; n < 2; ++n) _Pragma("unroll") for (int k = 0; k < 2; ++k) \
        acc[ai][bj][m][n] = __builtin_amdgcn_mfma_f32_16x16x32_bf16(Bt[n][k], At[m][k], acc[ai][bj][m][n], 0, 0, 0); __builtin_amdgcn_s_setprio(0); } while (0)
#define PG8_WAIT_V(n) asm volatile("s_waitcnt vmcnt(" #n ")" ::: "memory")
#define PG8_WAIT_L(n) asm volatile("s_waitcnt lgkmcnt(" #n ")" ::: "memory")
#define PG8_BAR __builtin_amdgcn_s_barrier()
#define PG8_SCHED __builtin_amdgcn_sched_barrier(0)
    Unit cur, nxt; int ui = 0;
    if (!S.next(0, cur)) return;
    f32x4 acc[2][2][4][2];
#pragma unroll
    for (int a = 0; a < 2; ++a)
#pragma unroll
        for (int b = 0; b < 2; ++b)
#pragma unroll
            for (int m = 0; m < 4; ++m)
#pragma unroll
                for (int n = 0; n < 2; ++n) acc[a][b][m][n] = (f32x4){0.f, 0.f, 0.f, 0.f};
    bf16x8 At[4][2], B0[2][2], B1[2][2];
    const char* cA = (const char*)g.A + (size_t)cur.pm * tstepA; const char* cB = (const char*)g.Bt + (size_t)cur.pn * tstepB;
    PG8_STAGE(PG8_SB(0, 0), cB, voffB); PG8_STAGE(PG8_SB(0, 1), cB + hstepB, voffB); PG8_STAGE(PG8_SA(0, 0), cA, voffA); PG8_STAGE(PG8_SA(0, 1), cA + hstepA, voffA);
    if (wr == 1) PG8_BAR;
    PG8_WAIT_V(2); PG8_BAR;
    PG8_STAGE(PG8_SB(1, 0), cB + kstep, voffB); PG8_STAGE(PG8_SA(1, 0), cA + kstep, voffA); PG8_STAGE(PG8_SB(1, 1), cB + hstepB + kstep, voffB);
    PG8_WAIT_V(6); PG8_BAR;
    for (;;) {
        const bool has_next = S.next(ui + 1, nxt);
        const char* nA = has_next ? (const char*)g.A + (size_t)nxt.pm * tstepA : cA; const char* nB = has_next ? (const char*)g.Bt + (size_t)nxt.pn * tstepB : cB;
        for (int t = 0; t < nt; t += 2) {
            const bool last = (t == nt - 2);
            const char* a1 = cA + (size_t)(t + 1) * kstep;
            const char* a2 = last ? nA : cA + (size_t)(t + 2) * kstep; const char* b2 = last ? nB : cB + (size_t)(t + 2) * kstep;
            const char* a3 = a2 + kstep; const char* b3 = b2 + kstep;
            PG8_LDB(B0, 0, 0); PG8_LDB(B1, 0, 1); PG8_SCHED; PG8_LDA(At, 0, 0); PG8_STAGE(PG8_SA(1, 1), a1 + hstepA, voffA);
            PG8_WAIT_V(8); PG8_WAIT_L(0); PG8_BAR; PG8_MMA(0, 0, At, B0); PG8_MMA(0, 1, At, B1); PG8_BAR; PG8_SCHED;
            PG8_LDA(At, 0, 1); PG8_STAGE(PG8_SB(0, 0), b2, voffB); PG8_STAGE(PG8_SB(0, 1), b2 + hstepB, voffB); PG8_STAGE(PG8_SA(0, 0), a2, voffA);
            PG8_WAIT_V(8); PG8_WAIT_L(0); PG8_BAR; PG8_MMA(1, 0, At, B0); PG8_MMA(1, 1, At, B1); PG8_BAR; PG8_SCHED;
            PG8_LDB(B0, 1, 0); PG8_LDB(B1, 1, 1); PG8_SCHED; PG8_LDA(At, 1, 0); PG8_STAGE(PG8_SA(0, 1), a2 + hstepA, voffA);
            PG8_WAIT_V(8); PG8_WAIT_L(0); PG8_BAR; PG8_MMA(0, 0, At, B0); PG8_MMA(0, 1, At, B1); PG8_BAR; PG8_SCHED;
            PG8_LDA(At, 1, 1); PG8_STAGE(PG8_SB(1, 0), b3, voffB); PG8_STAGE(PG8_SB(1, 1), b3 + hstepB, voffB); PG8_STAGE(PG8_SA(1, 0), a3, voffA);
            PG8_WAIT_V(8); PG8_WAIT_L(0); PG8_BAR; PG8_MMA(1, 0, At, B0); PG8_MMA(1, 1, At, B1); PG8_BAR; PG8_SCHED;
        }
        if constexpr (ALIGN_EPI) { if (wr == 0) PG8_BAR; }
        E(acc, cur, wr, wc, fr, fq);
        if (!has_next) break;
#pragma unroll
        for (int a = 0; a < 2; ++a)
#pragma unroll
            for (int b = 0; b < 2; ++b)
#pragma unroll
                for (int m = 0; m < 4; ++m)
#pragma unroll
                    for (int n = 0; n < 2; ++n) acc[a][b][m][n] = (f32x4){0.f, 0.f, 0.f, 0.f};
        cur = nxt; cA = nA; cB = nB; ++ui;
        if constexpr (ALIGN_EPI) { if (wr == 1) PG8_BAR; }
    }
    PG8_WAIT_V(0);
    if constexpr (!ALIGN_EPI) { if (wr == 0) PG8_BAR; }
    PG8_BAR;
#undef PG8_SA
#undef PG8_SB
#undef PG8_STAGE
#undef PG8_LDA
#undef PG8_LDB
#undef PG8_MMA
#undef PG8_WAIT_V
#undef PG8_WAIT_L
#undef PG8_BAR
#undef PG8_SCHED
}
}

namespace {
using pg8::bf16_t; using pg8::bf16x8; using pg8::f32x4; using pg8::u32x4; using pg8::u32x2; using pg8::Unit; using pg8::cvt_pk_bf16;
#define LAS __attribute__((address_space(3)))
constexpr int NWAVES = 8;
constexpr int RING_BYTES = 131072, LDSCTL_OFF = RING_BYTES, MISC_OFF = LDSCTL_OFF + 320, LDS_BYTES = 147456;

__device__ __forceinline__ unsigned f2bf(float f) { unsigned u = __float_as_uint(f); return (u + 0x7fffu + ((u >> 16) & 1u)) >> 16; }
__device__ __forceinline__ float bf2f(unsigned b) { return __uint_as_float(b << 16); }
__device__ __forceinline__ unsigned pk2(float lo, float hi) { return f2bf(lo) | (f2bf(hi) << 16); }
__device__ __forceinline__ float wave_sum(float v) {
#pragma unroll
    for (int o = 1; o < 64; o <<= 1) v += __shfl_xor(v, o);
    return v;
}
__device__ __forceinline__ float hsum(f32x4 v) { return (v.x + v.y) + (v.z + v.w); }
__device__ __forceinline__ float hsq(f32x4 v) { return (v.x * v.x + v.y * v.y) + (v.z * v.z + v.w * v.w); }

__device__ __forceinline__ const float* xrow_ptr(const Params& p, int t) {
    if (t < TP) { const int b = t / PL, q = t - b * PL; return q < NMETA ? p.meta + (size_t)q * D : p.x_prompt + ((size_t)b * SEQ + (q - NMETA)) * D; }
    return p.x_sample + (size_t)(t - TP) * D;
}
__device__ __forceinline__ float* yrow_ptr(const Params& p, int t) {
    if (t < TP) { const int b = t / PL, q = t - b * PL; return q < NMETA ? nullptr : p.out + O_YP + ((size_t)b * SEQ + (q - NMETA)) * D; }
    if (t < T) return p.out + O_YS + (size_t)(t - TP) * D;
    return nullptr;
}

#define XB_TMO      128
#define XB_XCNT(j)  (256  + 64 * (j))
#define XB_XSUB(j)  (1280 + 64 * (j))
#define XB_XGEN(j)  (2304 + 64 * (j))
#define XB_TOP      3328
#define XB_TOPGEN   3392
#define XCD_BAR_WORDS 3456
#define XB_SPIN_CAP (1u << 18)
__device__ __forceinline__ unsigned xb_ld(unsigned* p)              { return __hip_atomic_load(p, __ATOMIC_RELAXED, __HIP_MEMORY_SCOPE_AGENT); }
__device__ __forceinline__ unsigned xb_add(unsigned* p, unsigned v) { return __hip_atomic_fetch_add(p, v, __ATOMIC_RELAXED, __HIP_MEMORY_SCOPE_AGENT); }
__device__ __forceinline__ unsigned xb_xcc_id() { return (unsigned)__builtin_amdgcn_s_getreg((3 << 11) | 20) & 0xFu; }
#define XB_SPIN(cond, bar) do { unsigned _sp = 0; while (cond) { __builtin_amdgcn_s_sleep(1); \
    if ((++_sp & 255u) == 0u) { if (xb_ld(&(bar)[XB_TMO])) break; if (_sp > XB_SPIN_CAP) { atomicAdd(&(bar)[XB_TMO], 1u); break; } } } } while (0)
struct XcdBarrier { unsigned* bar; unsigned x; volatile LAS unsigned* st; int wave; };
__device__ __forceinline__ bool xb_leader(int wave) { return wave == 0 && pg8::lane_id_fresh() == 0; }
__device__ __forceinline__ XcdBarrier xcd_barrier_post(unsigned* bar, volatile LAS unsigned* st, int wave) {
    XcdBarrier b; b.bar = bar; b.x = xb_xcc_id(); b.st = st; b.wave = wave;
    if (xb_leader(wave)) (void)xb_add(&bar[XB_XCNT(b.x)], 1u);
    return b;
}
__device__ __forceinline__ void xcd_barrier_complete(unsigned* bar, unsigned x, unsigned& nloc, unsigned& nx) {
    const unsigned G = gridDim.x * gridDim.y * gridDim.z;
    unsigned sum, cnt, mine, sp = 0u;
    for (;;) {
        sum = 0u; cnt = 0u; mine = 0u;
#pragma unroll
        for (unsigned j = 0; j < 16; ++j) { const unsigned c = xb_ld(&bar[XB_XCNT(j)]); sum += c; cnt += (c > 0u) ? 1u : 0u; mine = (j == x) ? c : mine; }
        if (sum == G) break;
        __builtin_amdgcn_s_sleep(1);
        if ((++sp & 255u) == 0u) { if (xb_ld(&bar[XB_TMO])) break; if (sp > XB_SPIN_CAP) { atomicAdd(&bar[XB_TMO], 1u); break; } }
    }
    nloc = mine > 0u ? mine : 1u; nx = cnt > 0u ? cnt : 1u;
}
__device__ __forceinline__ void xcd_barrier(const XcdBarrier& b) {
    asm volatile("s_waitcnt vmcnt(0)" ::: "memory");
    __syncthreads();
    if (xb_leader(b.wave)) {
        unsigned* bar = b.bar;
        __builtin_amdgcn_s_waitcnt(0);
        unsigned nloc = b.st[0], nx = b.st[1];
        if (nloc == 0u) { xcd_barrier_complete(bar, b.x, nloc, nx); b.st[0] = nloc; b.st[1] = nx; }
        const unsigned old = xb_add(&bar[XB_XSUB(b.x)], 1u);
        const unsigned gen = old / nloc;
        if (old + 1u == (gen + 1u) * nloc) {
            __builtin_amdgcn_fence(__ATOMIC_RELEASE, "agent");
            asm volatile("s_waitcnt vmcnt(0)" ::: "memory");
            const unsigned og = xb_add(&bar[XB_TOP], 1u);
            const unsigned tg = og / nx;
            if (og + 1u == (tg + 1u) * nx) xb_add(&bar[XB_TOPGEN], 1u);
            else XB_SPIN(xb_ld(&bar[XB_TOPGEN]) == tg, bar);
            __builtin_amdgcn_fence(__ATOMIC_ACQUIRE, "agent");
            xb_add(&bar[XB_XGEN(b.x)], 1u);
            asm volatile("s_waitcnt vmcnt(0)" ::: "memory");
        } else {
            XB_SPIN(xb_ld(&bar[XB_XGEN(b.x)]) == gen, bar);
            __builtin_amdgcn_fence(__ATOMIC_ACQUIRE, "agent");
            asm volatile("s_waitcnt vmcnt(0)" ::: "memory");
        }
    }
    __syncthreads();
}

struct EpiIn {
    static constexpr bool PERM = true;
    bf16_t* O; const float* r0;
    __device__ __forceinline__ void operator()(const f32x4 (&acc)[2][2][4][2], const Unit& u, int wr, int wc, int fr_, int fq_) const {
        const int lane_e = pg8::lane_id_fresh(), fr = lane_e & 15, fq = lane_e >> 4;
        const int row0 = u.pm * 256 + wr * 64 + fr, col0 = u.pn * 256 + wc * 32 + 8 * fq;
#pragma unroll
        for (int ai = 0; ai < 2; ++ai)
#pragma unroll
            for (int m = 0; m < 4; ++m) { const int row = row0 + ai * 128 + m * 16; const float sc = r0[row]; bf16_t* rowp = O + (size_t)row * NIN + col0;
#pragma unroll
                for (int bj = 0; bj < 2; ++bj) { const f32x4 v0 = acc[ai][bj][m][0] * sc, v1 = acc[ai][bj][m][1] * sc;
                    u32x4 w; w.x = cvt_pk_bf16(v0[0], v0[1]); w.y = cvt_pk_bf16(v0[2], v0[3]); w.z = cvt_pk_bf16(v1[0], v1[1]); w.w = cvt_pk_bf16(v1[2], v1[3]);
                    *(u32x4*)(rowp + bj * 128) = w; } }
    }
};
struct EpiOut {
    static constexpr bool PERM = true;
    Params p; bf16_t* x1b; float* ssq;
    __device__ __forceinline__ void operator()(const f32x4 (&acc)[2][2][4][2], const Unit& u, int wr, int wc, int fr_, int fq_) const {
        const int lane_e = pg8::lane_id_fresh(), fr = lane_e & 15, fq = lane_e >> 4;
        const int row0 = u.pm * 256 + wr * 64 + fr, col0 = u.pn * 256 + wc * 32 + 8 * fq;
#pragma unroll
        for (int am = 0; am < 4; ++am) { const int ai = am >> 1;
            f32x4 xv[2][2][2];
#pragma unroll
            for (int mm = 0; mm < 2; ++mm) { const int m = (am & 1) * 2 + mm; const int row = row0 + ai * 128 + m * 16; const float* xr = xrow_ptr(p, row < T ? row : 0);
#pragma unroll
                for (int bj = 0; bj < 2; ++bj) { xv[mm][bj][0] = *(const f32x4*)(xr + col0 + bj * 128); xv[mm][bj][1] = *(const f32x4*)(xr + col0 + bj * 128 + 4); } }
#pragma unroll
            for (int mm = 0; mm < 2; ++mm) { const int m = (am & 1) * 2 + mm; const int row = row0 + ai * 128 + m * 16; const float keep = row < T ? 1.f : 0.f; float* yr = yrow_ptr(p, row); float ss = 0.f;
#pragma unroll
                for (int bj = 0; bj < 2; ++bj) { const int col = col0 + bj * 128; const f32x4 a0 = acc[ai][bj][m][0] + xv[mm][bj][0] * keep, a1 = acc[ai][bj][m][1] + xv[mm][bj][1] * keep;
                    if (yr) { *(f32x4*)(yr + col) = a0; *(f32x4*)(yr + col + 4) = a1; }
                    u32x4 w; w.x = cvt_pk_bf16(a0[0], a0[1]); w.y = cvt_pk_bf16(a0[2], a0[3]); w.z = cvt_pk_bf16(a1[0], a1[1]); w.w = cvt_pk_bf16(a1[2], a1[3]);
                    *(u32x4*)(x1b + (size_t)row * D + col) = w; ss += hsq(a0) + hsq(a1); }
                ss += __shfl_xor(ss, 16); ss += __shfl_xor(ss, 32);
                if (fq == 0) atomicAdd(ssq + row, ss); }
        }
    }
};
struct EpiDown {
    static constexpr bool PERM = true;
    Params p; float* ssq;
    __device__ __forceinline__ void operator()(const f32x4 (&acc)[2][2][4][2], const Unit& u, int wr, int wc, int fr_, int fq_) const {
        const int lane_e = pg8::lane_id_fresh(), fr = lane_e & 15, fq = lane_e >> 4;
        const int row0 = u.pm * 256 + wr * 64 + fr, col0 = u.pn * 256 + wc * 32 + 8 * fq;
#pragma unroll
        for (int am = 0; am < 4; ++am) { const int ai = am >> 1;
            f32x4 xv[2][2][2];
#pragma unroll
            for (int mm = 0; mm < 2; ++mm) { const int m = (am & 1) * 2 + mm; const int row = row0 + ai * 128 + m * 16; const float* yr = yrow_ptr(p, row); const float* ld = yr ? yr : p.out;
#pragma unroll
                for (int bj = 0; bj < 2; ++bj) { xv[mm][bj][0] = *(const f32x4*)(ld + col0 + bj * 128); xv[mm][bj][1] = *(const f32x4*)(ld + col0 + bj * 128 + 4); } }
#pragma unroll
            for (int mm = 0; mm < 2; ++mm) { const int m = (am & 1) * 2 + mm; const int row = row0 + ai * 128 + m * 16; float* yr = yrow_ptr(p, row); float ss = 0.f;
#pragma unroll
                for (int bj = 0; bj < 2; ++bj) { const int col = col0 + bj * 128; const f32x4 a0 = acc[ai][bj][m][0] + xv[mm][bj][0], a1 = acc[ai][bj][m][1] + xv[mm][bj][1];
                    if (yr) { *(f32x4*)(yr + col) = a0; *(f32x4*)(yr + col + 4) = a1; } ss += hsq(a0) + hsq(a1); }
                ss += __shfl_xor(ss, 16); ss += __shfl_xor(ss, 32);
                if (fq == 0) ssq[(size_t)row * 16 + u.pn * 4 + wc] = yr ? ss : 0.f; }
        }
    }
};
struct EpiUp {
    static constexpr bool PERM = true;
    const float* cw; const float* cb; float* ups; float* out; const float* ssq1; bf16_t* act;
    template <int CTRL> static __device__ __forceinline__ float dpp(float x) { return __builtin_bit_cast(float, __builtin_amdgcn_mov_dpp(__builtin_bit_cast(int, x), CTRL, 0xf, 0xf, true)); }
    typedef float f32x2 __attribute__((ext_vector_type(2)));
    static __device__ __forceinline__ f32x2 ld2(const float* p) { const float2 v = *(const float2*)p; return (f32x2){v.x, v.y}; }
    static __device__ __forceinline__ f32x2 bld2(__amdgpu_buffer_rsrc_t r, int voff, int soff) { return __builtin_bit_cast(f32x2, __builtin_amdgcn_raw_buffer_load_b64(r, voff, soff, 0)); }
    static __device__ __forceinline__ f32x2 fma2(f32x2 a, f32x2 b, f32x2 c) { return __builtin_elementwise_fma(a, b, c); }
    template <bool BND, bool SMPS>
    __device__ __forceinline__ void half(const f32x4 (&acc)[2][2][4][2], const int ai, const int tb, const int ch0, const int fr, __amdgpu_buffer_rsrc_t rw, __amdgpu_buffer_rsrc_t rb) const {
        float r1[4]; bool k1[4], k2[4]; int foff[4]; bool anyf = false;
        float q1[4];
#pragma unroll
        for (int m = 0; m < 4; ++m) { const int t = tb + 16 * m + fr; q1[m] = ssq1[t < 0 ? 0 : t]; }
#pragma unroll
        for (int m = 0; m < 4; ++m) { const int t = tb + 16 * m + fr; const float s = q1[m];
            r1[m] = t >= 0 ? rsqrtf(s * (1.f / D) + EPS) : 0.f;
            const bool valid = (m > 0 || fr >= 2) && t < T, isp = !SMPS || t < TP;
            const int b = t / PL, posp = t - b * PL;
            const bool want = valid && (isp ? posp >= PL - 2 : true);
            const int fo = isp ? (int)O_FP + (b * 2 + (posp - (PL - 2))) * NUP : (t - TP) * NUP;
            k1[m] = posp >= 1; k2[m] = posp >= 2; foff[m] = want ? fo : -1; anyf = anyf || want; }
        unsigned ov[4][4];
#pragma unroll
        for (int c4 = 0; c4 < 4; ++c4) { const int n = c4 >> 1, eh = c4 & 1, ch = ch0 + 2 * c4;
            const f32x2 w0v = bld2(rw, ch * 4, 0), w1v = bld2(rw, ch * 4, NUP * 4), w2v = bld2(rw, ch * 4, 2 * NUP * 4), bv = bld2(rb, ch * 4, 0);
            const f32x2 w0g = bld2(rw, ch * 4, DFF * 4), w1g = bld2(rw, ch * 4, (NUP + DFF) * 4), w2g = bld2(rw, ch * 4, (2 * NUP + DFF) * 4), bg = bld2(rb, ch * 4, DFF * 4);
            const f32x2 z2 = (f32x2){0.f, 0.f};
            f32x2 pr1v = z2, pr2v = z2, pr1g = z2, pr2g = z2;
#pragma unroll
            for (int m = 0; m < 4; ++m) {
                const f32x2 rr = (f32x2){r1[m], r1[m]};
                const f32x2 Vv = (f32x2){acc[ai][0][m][n][2 * eh], acc[ai][0][m][n][2 * eh + 1]} * rr, Vg = (f32x2){acc[ai][1][m][n][2 * eh], acc[ai][1][m][n][2 * eh + 1]} * rr;
                const f32x2 c1v = (f32x2){dpp<0x121>(Vv.x), dpp<0x121>(Vv.y)}, c2v = (f32x2){dpp<0x122>(Vv.x), dpp<0x122>(Vv.y)};
                const f32x2 c1g = (f32x2){dpp<0x121>(Vg.x), dpp<0x121>(Vg.y)}, c2g = (f32x2){dpp<0x122>(Vg.x), dpp<0x122>(Vg.y)};
                f32x2 p1v = fr >= 1 ? c1v : pr1v, p2v = fr >= 2 ? c2v : pr2v, p1g = fr >= 1 ? c1g : pr1g, p2g = fr >= 2 ? c2g : pr2g;
                pr1v = c1v; pr2v = c2v; pr1g = c1g; pr2g = c2g;
                if (BND) { p1v = k1[m] ? p1v : z2; p1g = k1[m] ? p1g : z2; p2v = k2[m] ? p2v : z2; p2g = k2[m] ? p2g : z2; }
                const f32x2 val = fma2(w0v, p2v, fma2(w1v, p1v, fma2(w2v, Vv, bv))), gate = fma2(w0g, p2g, fma2(w1g, p1g, fma2(w2g, Vg, bg)));
                const f32x2 ng = gate * (-1.4426950408889634f);
                f32x2 ex; ex.x = __builtin_amdgcn_exp2f(ng.x); ex.y = __builtin_amdgcn_exp2f(ng.y);
                const f32x2 den = ex + 1.0f;
                f32x2 rc; rc.x = __builtin_amdgcn_rcpf(den.x); rc.y = __builtin_amdgcn_rcpf(den.y);
                const f32x2 av = (val * gate) * rc;
                ov[m][c4] = cvt_pk_bf16(av.x, av.y);
            } }
#pragma unroll
        for (int m = 0; m < 4; ++m) { const int t = tb + 16 * m + fr; const bool valid = (m > 0 || fr >= 2) && (SMPS ? t < TP : t < T);
            if (valid) { u32x4 w; w.x = ov[m][0]; w.y = ov[m][1]; w.z = ov[m][2]; w.w = ov[m][3]; *(u32x4*)(act + (size_t)t * DFF + ch0) = w; } }
        if (__any(anyf)) {
#pragma unroll
            for (int m = 0; m < 4; ++m) if (foff[m] >= 0) { const int t = tb + 16 * m + fr;
                if (SMPS && t >= TP) { float* o = ups + foff[m] + ch0;
#pragma unroll
                    for (int n = 0; n < 2; ++n) { *(f32x4*)(o + 4 * n) = acc[ai][0][m][n] * r1[m]; *(f32x4*)(o + DFF + 4 * n) = acc[ai][1][m][n] * r1[m]; } }
                else { float* o = out + foff[m] + ch0;
#pragma unroll
                    for (int n = 0; n < 2; ++n) { *(f32x4*)(o + 4 * n) = acc[ai][0][m][n] * r1[m]; *(f32x4*)(o + DFF + 4 * n) = acc[ai][1][m][n] * r1[m]; } } }
        }
    }
    __device__ __forceinline__ void operator()(const f32x4 (&acc)[2][2][4][2], const Unit& u, int wr, int wc, int fr_, int fq_) const {
        const int lane_e = pg8::lane_id_fresh(), fr = lane_e & 15, fq = lane_e >> 4;
        const int ch0 = u.pn * 128 + wc * 32 + 8 * fq;
        const __amdgpu_buffer_rsrc_t rw = __builtin_amdgcn_make_buffer_rsrc((void*)cw, 0, 3 * NUP * 4, 0x00020000), rb = __builtin_amdgcn_make_buffer_rsrc((void*)cb, 0, NUP * 4, 0x00020000);
#pragma unroll
        for (int ai = 0; ai < 2; ++ai) {
            const int tb = ETILE * u.pm - 2 + EBLK * (2 * ai + wr);
            if (tb + 63 >= TP) half<true, true>(acc, ai, tb, ch0, fr, rw, rb);
            else { const int lo = tb < 0 ? 0 : tb, nxt = ((lo + PL - 1) / PL) * PL;
                   const bool bnd = (nxt <= tb + 63) || (lo - (lo / PL) * PL) < 2;
                   if (bnd) half<true, false>(acc, ai, tb, ch0, fr, rw, rb); else half<false, false>(acc, ai, tb, ch0, fr, rw, rb); }
        }
    }
};
__device__ __forceinline__ void p4b_phase(const Params& p, int gw, int NGW) {
    const int lane = pg8::lane_id_fresh();
    const float* ups = (const float*)(p.ws + WS_UPS); bf16_t* act = (bf16_t*)(p.ws + WS_ACT);
    for (int it = gw; it < TS * (DFF / 256); it += NGW) {
        const int row = it / (DFF / 256), ch = (it - row * (DFF / 256)) * 256 + 4 * lane, sq = row >> 2, j = row & 3;
        const float* c0 = ups + (size_t)row * NUP + ch; const float* c1 = ups + (size_t)(j >= 1 ? row - 1 : row) * NUP + ch; const float* c2 = ups + (size_t)(j >= 2 ? row - 2 : row) * NUP + ch;
        const float* s1 = p.state_ffn + ((size_t)sq * 2 + 1) * NUP + ch; const float* s2 = p.state_ffn + ((size_t)sq * 2 + (j & 1)) * NUP + ch;
        const f32x4 uv = *(const f32x4*)c0, ug = *(const f32x4*)(c0 + DFF), a1v = *(const f32x4*)c1, a1g = *(const f32x4*)(c1 + DFF), a2v = *(const f32x4*)c2, a2g = *(const f32x4*)(c2 + DFF);
        const f32x4 t1v = *(const f32x4*)s1, t1g = *(const f32x4*)(s1 + DFF), t2v = *(const f32x4*)s2, t2g = *(const f32x4*)(s2 + DFF);
        const float* cw = p.ffn_conv_w + ch; const float* cb = p.ffn_conv_b + ch;
        const f32x4 w0v = *(const f32x4*)cw, w1v = *(const f32x4*)(cw + NUP), w2v = *(const f32x4*)(cw + 2 * NUP), bv = *(const f32x4*)cb;
        const f32x4 w0g = *(const f32x4*)(cw + DFF), w1g = *(const f32x4*)(cw + NUP + DFF), w2g = *(const f32x4*)(cw + 2 * NUP + DFF), bg = *(const f32x4*)(cb + DFF);
        const f32x4 p1v = j >= 1 ? a1v : t1v, p1g = j >= 1 ? a1g : t1g, p2v = j >= 2 ? a2v : t2v, p2g = j >= 2 ? a2g : t2g;
        const f32x4 val = w0v * p2v + w1v * p1v + w2v * uv + bv, gate = w0g * p2g + w1g * p1g + w2g * ug + bg;
        f32x4 a;
#pragma unroll
        for (int e = 0; e < 4; ++e) a[e] = val[e] * gate[e] * __builtin_amdgcn_rcpf(1.f + __builtin_amdgcn_exp2f(gate[e] * -1.4426950408889634f));
        u32x2 o; o.x = cvt_pk_bf16(a[0], a[1]); o.y = cvt_pk_bf16(a[2], a[3]); *(u32x2*)(act + (size_t)(TP + row) * DFF + ch) = o;
        if (j >= DS - 2) { float* d = p.out + O_FS + ((size_t)sq * 2 + (j - (DS - 2))) * NUP + ch; *(f32x4*)d = uv; *(f32x4*)(d + DFF) = ug; }
    }
}

__device__ __forceinline__ int wup_src_col(int n) { const int pn = n >> 8, w = n & 255, bj = w >> 7, c = w & 127; return bj * DFF + 128 * pn + c; }
template <bool MAP>
__device__ __forceinline__ void p0_transpose_item(const float* W, int K, int N, int NP, bf16_t* WT, const float* gain, LAS float* scr, int item, int lane) {
    const int nblk = NP / 32, kb = item / nblk, nb = item % nblk, k0 = 64 * kb, n0 = 32 * nb, s0 = MAP ? wup_src_col(n0) : n0;
    float v[32];
#pragma unroll
    for (int i = 0; i < 32; ++i) { const int kk = 2 * i + (lane >> 5); v[i] = W[(size_t)(k0 + kk) * N + s0 + (lane & 31)]; }
    const int c = lane & 7;
    f32x4 g0 = (f32x4){1.f, 1.f, 1.f, 1.f}, g1 = g0;
    if (gain) { g0 = *(const f32x4*)(gain + k0 + 8 * c); g1 = *(const f32x4*)(gain + k0 + 8 * c + 4); }
#pragma unroll
    for (int i = 0; i < 32; ++i) { const int kk = 2 * i + (lane >> 5); scr[kk * 33 + (lane & 31)] = v[i]; }
    asm volatile("s_waitcnt lgkmcnt(0)" ::: "memory");
#pragma unroll
    for (int j = 0; j < 4; ++j) { const int n = (lane >> 3) + 8 * j; const LAS float* s = scr + (8 * c) * 33 + n;
        u32x4 o; o.x = pk2(s[0 * 33] * g0.x, s[1 * 33] * g0.y); o.y = pk2(s[2 * 33] * g0.z, s[3 * 33] * g0.w); o.z = pk2(s[4 * 33] * g1.x, s[5 * 33] * g1.y); o.w = pk2(s[6 * 33] * g1.z, s[7 * 33] * g1.w);
        *(u32x4*)(WT + (size_t)(n0 + n) * K + k0 + 8 * c) = o; }
    asm volatile("s_waitcnt lgkmcnt(0)" ::: "memory");
}
__device__ __forceinline__ void p0_prologue(const Params& p, LAS unsigned char* lds, int gw, int NGW, int wave) {
    const int lane = pg8::lane_id_fresh();
    LAS float* scr = (LAS float*)(lds + wave * 16384);
    bf16_t* win = (bf16_t*)(p.ws + WS_WIN); bf16_t* wout = (bf16_t*)(p.ws + WS_WOUT); bf16_t* wup = (bf16_t*)(p.ws + WS_WUP); bf16_t* wdown = (bf16_t*)(p.ws + WS_WDOWN); bf16_t* wpool = (bf16_t*)(p.ws + WS_WPOOL);
    constexpr int I_IN = (D / 64) * (NIN / 32), I_OUT = (D / 64) * (D / 32), I_UP = (D / 64) * (NUP / 32), I_DN = (DFF / 64) * (D / 32), I_PL = 4 * (128 / 64) * (128 / 32);
    constexpr int NITEMS = I_IN + I_OUT + I_UP + I_DN + I_PL;
    bf16_t* xb = (bf16_t*)(p.ws + WS_XB); float* r0 = (float*)(p.ws + WS_R0); bf16_t* mix = (bf16_t*)(p.ws + WS_MIX); bf16_t* x1b = (bf16_t*)(p.ws + WS_X1B);
    for (int tq = gw; tq < T / 4; tq += NGW) {
        f32x4 v[4][4];
#pragma unroll
        for (int r = 0; r < 4; ++r) { const f32x4* xr = (const f32x4*)xrow_ptr(p, 4 * tq + r) + lane;
#pragma unroll
            for (int j = 0; j < 4; ++j) v[r][j] = xr[64 * j]; }
#pragma unroll
        for (int r = 0; r < 4; ++r) { const int t = 4 * tq + r; float s = 0.f;
#pragma unroll
            for (int j = 0; j < 4; ++j) s += hsq(v[r][j]);
            s = wave_sum(s);
            if (lane == 0) r0[t] = rsqrtf(s * (1.f / D) + EPS);
            unsigned long long* o8 = (unsigned long long*)(xb + (size_t)t * D) + lane;
#pragma unroll
            for (int j = 0; j < 4; ++j) o8[64 * j] = (unsigned long long)pk2(v[r][j].x, v[r][j].y) | ((unsigned long long)pk2(v[r][j].z, v[r][j].w) << 32); }
    }
    { float* ssq1 = (float*)(p.ws + WS_SSQ1); for (int t = gw * 64 + lane; t < MPAD; t += NGW * 64) ssq1[t] = 0.f; }
    for (int t = T + gw; t < MPAD + X1B_PADROWS; t += NGW) {
        if (t >= MPAD) { unsigned long long* o8 = (unsigned long long*)(x1b + (size_t)(t - MPAD) * D) + lane; for (int j = 0; j < 4; ++j) o8[64 * j] = 0ull; continue; }
        unsigned long long* o8 = (unsigned long long*)(xb + (size_t)t * D) + lane; unsigned long long* m8 = (unsigned long long*)(mix + (size_t)t * D) + lane;
        for (int j = 0; j < 4; ++j) { o8[64 * j] = 0ull; m8[64 * j] = 0ull; } if (lane == 0) r0[t] = 0.f;
    }
    for (int it = gw; it < NITEMS; it += NGW) {
        int r = it;
        if (r < I_IN) { p0_transpose_item<false>(p.w_in, D, NIN, NIN, win, p.norm_mix, scr, r, lane); continue; } r -= I_IN;
        if (r < I_UP) { p0_transpose_item<true>(p.w_up, D, NUP, NUP, wup, p.norm_ffn, scr, r, lane); continue; } r -= I_UP;
        if (r < I_DN) { p0_transpose_item<false>(p.w_down, DFF, D, D, wdown, nullptr, scr, r, lane); continue; } r -= I_DN;
        if (r < I_OUT) { p0_transpose_item<false>(p.w_out, D, D, D, wout, nullptr, scr, r, lane); continue; } r -= I_OUT;
        { const int g = r >> 3; p0_transpose_item<false>(p.w_pool + (size_t)g * 16384, 128, 128, 128, wpool + (size_t)g * 16384, nullptr, scr, r & 7, lane); }
    }
}

constexpr int MIX_ROWB = 272;
template <int W>
__device__ __forceinline__ void pool_prompt_tile(const Params& p, const bf16_t* proj, LAS unsigned char* scr, int t0, int b, int p0, int g, int lane) {
    const int cu = 128 * g + 2 * lane;
    unsigned uw[31];
#pragma unroll
    for (int dr = 0; dr < 31; ++dr) { const int tr = t0 - 15 + dr; uw[dr] = *(const unsigned*)(proj + (size_t)(tr < 0 ? 0 : tr) * NIN + cu); }
    float ua[31], ub[31];
#pragma unroll
    for (int dr = 0; dr < 31; ++dr) { const unsigned w = (p0 - 15 + dr >= 0) ? uw[dr] : 0u; ua[dr] = bf2f(w & 0xffffu); ub[dr] = bf2f(w >> 16); }
    float ca[32], cb2[32]; ca[0] = 0.f; cb2[0] = 0.f;
#pragma unroll
    for (int dr = 0; dr < 31; ++dr) { ca[dr + 1] = ca[dr] + ua[dr]; cb2[dr + 1] = cb2[dr] + ub[dr]; }
#pragma unroll
    for (int i = 0; i < 16; ++i) {
        const int pos = p0 + i; const float inv = 1.f / (float)(pos + 1 < W ? pos + 1 : W);
        const float da = (ca[16 + i] - ca[16 + i - W]) * inv - ua[15 + i], db = (cb2[16 + i] - cb2[16 + i - W]) * inv - ub[15 + i];
        *(LAS unsigned*)(scr + i * MIX_ROWB + 4 * lane) = pk2(da, db);
        if (pos >= PL - PBUF) { float2 o; o.x = ua[15 + i]; o.y = ub[15 + i]; *(float2*)(p.out + O_PP + ((size_t)b * PBUF + (pos - (PL - PBUF))) * POOLW + cu) = o; }
    }
}
template <int W>
__device__ __forceinline__ void pool_sample_tile(const Params& p, const bf16_t* proj, LAS unsigned char* scr, int t0, int s0, int g, int lane) {
    const int cu = 128 * g + 2 * lane;
#pragma unroll
    for (int q = 0; q < 4; ++q) { const int sq = s0 + q;
        float2 ex[19];
#pragma unroll
        for (int r = 0; r < 15; ++r) ex[r] = *(const float2*)(p.state_pool + ((size_t)sq * PBUF + r) * POOLW + cu);
#pragma unroll
        for (int j = 0; j < 4; ++j) { const unsigned w = *(const unsigned*)(proj + (size_t)(t0 + 4 * q + j) * NIN + cu); ex[15 + j].x = bf2f(w & 0xffffu); ex[15 + j].y = bf2f(w >> 16); }
        float ca[20], cb2[20]; ca[0] = 0.f; cb2[0] = 0.f;
#pragma unroll
        for (int r = 0; r < 19; ++r) { ca[r + 1] = ca[r] + ex[r].x; cb2[r + 1] = cb2[r] + ex[r].y; }
#pragma unroll
        for (int j = 0; j < 4; ++j) { const float inv = 1.f / (float)W;
            const float da = (ca[16 + j] - ca[16 + j - W]) * inv - ex[15 + j].x, db = (cb2[16 + j] - cb2[16 + j - W]) * inv - ex[15 + j].y;
            *(LAS unsigned*)(scr + (4 * q + j) * MIX_ROWB + 4 * lane) = pk2(da, db); }
#pragma unroll
        for (int r = 0; r < PBUF; ++r) *(float2*)(p.out + O_PS + ((size_t)sq * PBUF + r) * POOLW + cu) = ex[r + DS];
    }
}
__device__ __forceinline__ void mixer_phase(const Params& p, LAS unsigned char* lds, int gw, int NGW, int wave) {
    const int lane = pg8::lane_id_fresh();
    LAS unsigned char* scr = lds + wave * 8192;
    const bf16_t* proj = (const bf16_t*)(p.ws + WS_PROJ); bf16_t* mix = (bf16_t*)(p.ws + WS_MIX); const bf16_t* wpool = (const bf16_t*)(p.ws + WS_WPOOL);
    const int fr = lane & 15, fq = lane >> 4;
    constexpr int NITEM = (T / 16) * 4;
    for (int it = gw; it < NITEM; it += NGW) {
        const int tt = it >> 2, qd = it & 3, t0 = 16 * tt, g = qd, cc = 128 * qd + 2 * lane;
        const float2 w0 = *(const float2*)(p.conv_w + cc), w1 = *(const float2*)(p.conv_w + CONVW + cc), w2 = *(const float2*)(p.conv_w + 2 * CONVW + cc);
        if (t0 < TP) {
            const int b = t0 / PL, p0 = t0 - b * PL;
            unsigned zc[18], zv[18], zg[16];
#pragma unroll
            for (int dr = 0; dr < 18; ++dr) { const int tr = t0 - 2 + dr; const bf16_t* row = proj + (size_t)(tr < 0 ? 0 : tr) * NIN; zc[dr] = *(const unsigned*)(row + 1024 + cc); zv[dr] = *(const unsigned*)(row + 1536 + cc); }
#pragma unroll
            for (int i = 0; i < 16; ++i) zg[i] = *(const unsigned*)(proj + (size_t)(t0 + i) * NIN + 512 + cc);
            if (g == 0) pool_prompt_tile<2>(p, proj, scr, t0, b, p0, g, lane);
            else if (g == 1) pool_prompt_tile<4>(p, proj, scr, t0, b, p0, g, lane);
            else if (g == 2) pool_prompt_tile<8>(p, proj, scr, t0, b, p0, g, lane);
            else pool_prompt_tile<16>(p, proj, scr, t0, b, p0, g, lane);
            float za[18], zb[18];
#pragma unroll
            for (int dr = 0; dr < 18; ++dr) { const bool ok = p0 - 2 + dr >= 0; const unsigned wc_ = ok ? zc[dr] : 0u, wv = zv[dr];
                za[dr] = bf2f(wc_ & 0xffffu) * bf2f(wv & 0xffffu); zb[dr] = bf2f(wc_ >> 16) * bf2f(wv >> 16); }
#pragma unroll
            for (int i = 0; i < 16; ++i) { const unsigned wg = zg[i];
                const float ca_ = w0.x * za[i] + w1.x * za[i + 1] + w2.x * za[i + 2], cb_ = w0.y * zb[i] + w1.y * zb[i + 1] + w2.y * zb[i + 2];
                *(unsigned*)(mix + (size_t)(t0 + i) * D + 512 + cc) = pk2(bf2f(wg & 0xffffu) * ca_, bf2f(wg >> 16) * cb_);
                const int pos = p0 + i; if (pos >= PL - 2) { float2 o; o.x = za[i + 2]; o.y = zb[i + 2]; *(float2*)(p.out + O_CP + ((size_t)b * 2 + (pos - (PL - 2))) * CONVW + cc) = o; } }
        } else {
            const int s0 = (t0 - TP) >> 2;
            if (g == 0) pool_sample_tile<2>(p, proj, scr, t0, s0, g, lane);
            else if (g == 1) pool_sample_tile<4>(p, proj, scr, t0, s0, g, lane);
            else if (g == 2) pool_sample_tile<8>(p, proj, scr, t0, s0, g, lane);
            else pool_sample_tile<16>(p, proj, scr, t0, s0, g, lane);
#pragma unroll
            for (int q = 0; q < 4; ++q) { const int sq = s0 + q;
                float za[6], zb[6]; unsigned zg[4];
#pragma unroll
                for (int r = 0; r < 2; ++r) { const float2 s = *(const float2*)(p.state_conv + ((size_t)sq * 2 + r) * CONVW + cc); za[r] = s.x; zb[r] = s.y; }
#pragma unroll
                for (int j = 0; j < 4; ++j) { const bf16_t* row = proj + (size_t)(t0 + 4 * q + j) * NIN; const unsigned wc_ = *(const unsigned*)(row + 1024 + cc), wv = *(const unsigned*)(row + 1536 + cc);
                    za[2 + j] = bf2f(wc_ & 0xffffu) * bf2f(wv & 0xffffu); zb[2 + j] = bf2f(wc_ >> 16) * bf2f(wv >> 16); zg[j] = *(const unsigned*)(row + 512 + cc); }
#pragma unroll
                for (int j = 0; j < 4; ++j) { const float ca_ = w0.x * za[j] + w1.x * za[j + 1] + w2.x * za[j + 2], cb_ = w0.y * zb[j] + w1.y * zb[j + 1] + w2.y * zb[j + 2];
                    *(unsigned*)(mix + (size_t)(t0 + 4 * q + j) * D + 512 + cc) = pk2(bf2f(zg[j] & 0xffffu) * ca_, bf2f(zg[j] >> 16) * cb_);
                    if (j >= DS - 2) { float2 o; o.x = za[2 + j]; o.y = zb[2 + j]; *(float2*)(p.out + O_CS + ((size_t)sq * 2 + (j - (DS - 2))) * CONVW + cc) = o; } }
            }
        }
        asm volatile("s_waitcnt lgkmcnt(0)" ::: "memory");
        bf16x8 af[4];
#pragma unroll
        for (int s = 0; s < 4; ++s) af[s] = *(const LAS bf16x8*)(scr + fr * MIX_ROWB + (32 * s + 8 * fq) * 2);
#pragma unroll
        for (int nh = 0; nh < 2; ++nh) {
            bf16x8 bfr[4][4]; f32x4 sc[4];
#pragma unroll
            for (int nb = 0; nb < 4; ++nb) { sc[nb] = *(const f32x4*)(p.pool_scale + 128 * g + 16 * (4 * nh + nb) + 4 * fq);
#pragma unroll
                for (int s = 0; s < 4; ++s) bfr[nb][s] = *(const bf16x8*)(wpool + ((size_t)(g * 128 + 16 * (4 * nh + nb) + fr)) * 128 + 32 * s + 8 * fq); }
#pragma unroll
            for (int nb = 0; nb < 4; ++nb) { f32x4 a = (f32x4){0.f, 0.f, 0.f, 0.f};
#pragma unroll
                for (int s = 0; s < 4; ++s) a = __builtin_amdgcn_mfma_f32_16x16x32_bf16(bfr[nb][s], af[s], a, 0, 0, 0);
                const int col = 128 * g + 16 * (4 * nh + nb) + 4 * fq; a = a * sc[nb];
                u32x2 o; o.x = cvt_pk_bf16(a[0], a[1]); o.y = cvt_pk_bf16(a[2], a[3]); *(u32x2*)(mix + (size_t)(t0 + fr) * D + col) = o; } }
        asm volatile("s_waitcnt lgkmcnt(0)" ::: "memory");
    }
}

__device__ __forceinline__ void final_phase(const Params& p, int gw, int NGW) {
    const int lane = pg8::lane_id_fresh();
    const float* ssq2 = (const float*)(p.ws + WS_SSQ2);
    f32x4 gv[4];
#pragma unroll
    for (int j = 0; j < 4; ++j) gv[j] = *((const f32x4*)p.norm_final + lane + 64 * j);
    for (int tq = gw; tq < T / 4; tq += NGW) {
        float* y0 = yrow_ptr(p, 4 * tq); if (!y0) continue;
        f32x4 v[4][4], q4[4][4];
#pragma unroll
        for (int r = 0; r < 4; ++r) { const f32x4* yr = (const f32x4*)yrow_ptr(p, 4 * tq + r) + lane; const f32x4* q = (const f32x4*)(ssq2 + (size_t)(4 * tq + r) * 16);
#pragma unroll
            for (int j = 0; j < 4; ++j) { v[r][j] = yr[64 * j]; q4[r][j] = q[j]; } }
#pragma unroll
        for (int r = 0; r < 4; ++r) { const float s = (hsum(q4[r][0]) + hsum(q4[r][1])) + (hsum(q4[r][2]) + hsum(q4[r][3])); const float rr = rsqrtf(s * (1.f / D) + EPS);
            f32x4* yr = (f32x4*)yrow_ptr(p, 4 * tq + r) + lane;
#pragma unroll
            for (int j = 0; j < 4; ++j) yr[64 * j] = v[r][j] * rr * gv[j]; }
    }
}

struct Args { Params p; int mask; int bar_region; };
__global__ void __launch_bounds__(NWAVES * 64, 2) fwd_megakernel(Args args) {
    extern __shared__ __attribute__((aligned(16))) unsigned char lds_raw[];
    LAS unsigned char* lds = (LAS unsigned char*)lds_raw;
    const Params& p = args.p;
    const int wave = __builtin_amdgcn_readfirstlane((int)threadIdx.x >> 6), tid = wave * 64 + pg8::lane_id_fresh();
    const int G = gridDim.x, bx = blockIdx.x, vcu = (G % 8 == 0) ? (bx % 8) * (G / 8) + bx / 8 : bx;
    const int gw = vcu * NWAVES + wave, NGW = G * NWAVES;
    unsigned* ctl = (unsigned*)(p.ws + WS_CTL);
    for (int u = tid; u < (LDS_BYTES - LDSCTL_OFF) / 4; u += NWAVES * 64) ((LAS unsigned*)(lds + LDSCTL_OFF))[u] = 0u;
    __syncthreads();
    const XcdBarrier bar = xcd_barrier_post(ctl + CW_BAR + args.bar_region * XCD_BAR_WORDS, (volatile LAS unsigned*)(lds + MISC_OFF) + 8, wave);

    const int mask = args.mask;
    if (mask & 1) { p0_prologue(p, lds, gw, NGW, wave); xcd_barrier(bar); }
    if (mask & 2) { pg8::Gemm g{(const bf16_t*)(p.ws + WS_XB), (const bf16_t*)(p.ws + WS_WIN), D, 64}; pg8::StaticOrder S; S.init(NM, NIN / 256, G, bx);
      EpiIn E{(bf16_t*)(p.ws + WS_PROJ), (const float*)(p.ws + WS_R0)};
      pg8::gemm_phase<EpiIn, true>(lds, g, S, E, wave); xcd_barrier(bar); }
    if (mask & 4) { mixer_phase(p, lds, gw, NGW, wave); xcd_barrier(bar); }
    if (mask & 8) { pg8::Gemm g{(const bf16_t*)(p.ws + WS_MIX), (const bf16_t*)(p.ws + WS_WOUT), D, 64}; pg8::StaticOrder S; S.init(NM, D / 256, G, bx);
      EpiOut E{p, (bf16_t*)(p.ws + WS_X1B) + (size_t)X1B_PADROWS * D, (float*)(p.ws + WS_SSQ1)};
      pg8::gemm_phase<EpiOut, true>(lds, g, S, E, wave); xcd_barrier(bar); }
    if (mask & 16) { pg8::Gemm g{(const bf16_t*)(p.ws + WS_X1B) + (size_t)(X1B_PADROWS - 2) * D, (const bf16_t*)(p.ws + WS_WUP), D, EBLK}; pg8::StaticOrder S; S.init(NME, NUP / 256, G, bx);
      EpiUp E{p.ffn_conv_w, p.ffn_conv_b, (float*)(p.ws + WS_UPS), p.out, (const float*)(p.ws + WS_SSQ1), (bf16_t*)(p.ws + WS_ACT)};
      pg8::gemm_phase<EpiUp, true>(lds, g, S, E, wave); xcd_barrier(bar); p4b_phase(p, gw, NGW); xcd_barrier(bar); }
    if (mask & 32) { pg8::Gemm g{(const bf16_t*)(p.ws + WS_ACT), (const bf16_t*)(p.ws + WS_WDOWN), DFF, 64}; pg8::StaticOrder S; S.init(NM, D / 256, G, bx);
      EpiDown E{p, (float*)(p.ws + WS_SSQ2)};
      pg8::gemm_phase<EpiDown, true>(lds, g, S, E, wave); xcd_barrier(bar); }
    if (mask & 64) final_phase(p, gw, NGW);
}
}

extern "C" void kernel_launch(void* const* d_in, const int* in_sizes, int n_in, void* d_out, int out_size, void* d_ws, size_t ws_size, hipStream_t stream) {
    static int grid = 0;
    if (grid == 0) {
        if (n_in != 18 || ws_size < WS_END) { fprintf(stderr, "kernel_launch: unexpected inputs (n_in %d, ws %zu)\n", n_in, ws_size); grid = -1; return; }
        int dev = 0, cus = 0, per_cu = 0;
        if (hipGetDevice(&dev) != hipSuccess || hipDeviceGetAttribute(&cus, hipDeviceAttributeMultiprocessorCount, dev) != hipSuccess) { grid = -1; return; }
        if (hipFuncSetAttribute((const void*)fwd_megakernel, hipFuncAttributeMaxDynamicSharedMemorySize, LDS_BYTES) != hipSuccess) { fprintf(stderr, "kernel_launch: hipFuncSetAttribute failed\n"); grid = -1; return; }
        if (hipOccupancyMaxActiveBlocksPerMultiprocessor(&per_cu, (const void*)fwd_megakernel, NWAVES * 64, LDS_BYTES) != hipSuccess || per_cu < 1)
            fprintf(stderr, "kernel_launch: note: occupancy query reports %d workgroups per CU\n", per_cu);
        (void)hipGetLastError();
        grid = cus;
    }
    if (grid < 0) return;
    (void)hipMemsetAsync((char*)d_ws + WS_CTL, 0, CTL_ZERO_BYTES, stream);
    Args a{};
    Params& p = a.p;
    p.x_prompt = (const float*)d_in[0]; p.x_sample = (const float*)d_in[1]; p.state_pool = (const float*)d_in[2]; p.state_conv = (const float*)d_in[3]; p.state_ffn = (const float*)d_in[4];
    p.meta = (const float*)d_in[5]; p.norm_mix = (const float*)d_in[6]; p.w_in = (const float*)d_in[7]; p.w_pool = (const float*)d_in[8]; p.pool_scale = (const float*)d_in[9];
    p.conv_w = (const float*)d_in[10]; p.w_out = (const float*)d_in[11]; p.norm_ffn = (const float*)d_in[12]; p.w_up = (const float*)d_in[13]; p.ffn_conv_w = (const float*)d_in[14];
    p.ffn_conv_b = (const float*)d_in[15]; p.w_down = (const float*)d_in[16]; p.norm_final = (const float*)d_in[17];
    p.out = (float*)d_out; p.ws = (unsigned char*)d_ws;
    a.mask = 127; a.bar_region = 0;
    hipLaunchKernelGGL(fwd_megakernel, dim3(grid), dim3(NWAVES * 64), LDS_BYTES, stream, a);
#ifdef PROBE_MASK
    a.mask = PROBE_MASK; a.bar_region = 1;
    hipLaunchKernelGGL(fwd_megakernel, dim3(grid), dim3(NWAVES * 64), LDS_BYTES, stream, a);
#endif
    const hipError_t le = hipPeekAtLastError();
    if (le != hipSuccess) fprintf(stderr, "kernel_launch: launch failed: %s\n", hipGetErrorName(le));
}
```

```cpp
#include <hip/hip_runtime.h>
#include <cstdio>
#include <cstdint>

namespace {
constexpr int D = 1024, NB = 8, SEQ = 2048, NMETA = 16, PL = SEQ + NMETA, TP = NB * PL, DB = 128, DS = 4, TS = DB * DS, T = TP + TS;
constexpr int MPAD = 17152;
constexpr int POOLW = 512, CONVW = 512, NIN = 2048, DFF = 2816, NUP = 5632, PBUF = 15;
constexpr float EPS = 1e-6f;
constexpr int NM = MPAD / 256;
constexpr int EBLK = 62, ETILE = 4 * EBLK;
constexpr int NME = (T + ETILE - 1) / ETILE;
constexpr size_t O_YP = 0, O_YS = (size_t)NB * SEQ * D, O_PP = O_YS + (size_t)TS * D, O_CP = O_PP + (size_t)NB * PBUF * POOLW,
                 O_FP = O_CP + (size_t)NB * 2 * CONVW, O_PS = O_FP + (size_t)NB * 2 * NUP, O_CS = O_PS + (size_t)DB * PBUF * POOLW,
                 O_FS = O_CS + (size_t)DB * 2 * CONVW;
constexpr size_t MiB = 1u << 20;
constexpr size_t WS_CTL = 0, CTL_ZERO_BYTES = 64 * 1024;
constexpr size_t WS_R0 = 256 * 1024;
constexpr size_t WS_SSQ1 = 2 * MiB, WS_SSQ2 = 4 * MiB;
constexpr size_t WS_WIN = 6 * MiB, WS_WOUT = 10 * MiB, WS_WUP = 12 * MiB, WS_WDOWN = 23 * MiB, WS_WPOOL = 29 * MiB;
constexpr size_t WS_MIX = 30 * MiB, WS_X1B = 64 * MiB, WS_XB = 98 * MiB, WS_PROJ = 132 * MiB, WS_ACT = 98 * MiB, WS_UPS = 200 * MiB, WS_END = 212 * MiB;
constexpr int X1B_PADROWS = 16;
static_assert(WS_MIX + (size_t)MPAD * D * 2 <= WS_X1B && WS_X1B + (size_t)(MPAD + X1B_PADROWS) * D * 2 <= WS_XB && WS_XB + (size_t)MPAD * D * 2 <= WS_PROJ &&
              WS_PROJ + (size_t)MPAD * NIN * 2 <= WS_UPS && WS_UPS + (size_t)TS * NUP * 4 <= WS_END && WS_ACT + (size_t)MPAD * DFF * 2 <= WS_UPS && WS_WUP + (size_t)NUP * D * 2 <= WS_WDOWN && WS_WDOWN + (size_t)D * DFF * 2 <= WS_WPOOL, "d_ws map");
constexpr int CW_BAR = 1024;

struct Params {
    const float *x_prompt, *x_sample, *state_pool, *state_conv, *state_ffn, *meta, *norm_mix, *w_in, *w_pool, *pool_scale, *conv_w, *w_out,
        *norm_ffn, *w_up, *ffn_conv_w, *ffn_conv_b, *w_down, *norm_final;
    float* out; unsigned char* ws;
};
}

namespace pg8 {
#define PG8_LAS __attribute__((address_space(3)))
typedef unsigned short bf16_t;
typedef short bf16x8 __attribute__((ext_vector_type(8)));
typedef float f32x4 __attribute__((ext_vector_type(4)));
typedef unsigned u32x4 __attribute__((ext_vector_type(4)));
typedef unsigned u32x2 __attribute__((ext_vector_type(2)));
constexpr int BM = 256, BK = 64, HALF = 128, HTB = HALF * BK * 2  , STAGE_BYTES = 8 * HTB, NXCD = 8, WGM = 8;

__host__ __device__ __forceinline__ int lds_byte(int r, int c) { const int st = (r >> 4) * 2 + (c >> 5), rr = r & 15, cc = c & 31, ob = rr * 64 + cc * 2; return st * 1024 + (ob ^ (((ob >> 9) & 1) << 5)); }
__host__ __device__ __forceinline__ void stage_rc(int b, int& R, int& C) { const int st = b / 1024, sb = b % 1024, swz = sb ^ (((sb >> 9) & 1) << 5); R = (st >> 1) * 16 + swz / 64; C = (st & 1) * 32 + (swz % 64) / 2; }
__host__ __device__ __forceinline__ int perm32(int rho) { const int n = rho >> 4, i = rho & 15; return 8 * (i >> 2) + 4 * n + (i & 3); }

struct Unit { int pm, pn; };
struct Gemm { const bf16_t* A; const bf16_t* Bt; int K; int ablk; int amode; };
__device__ __forceinline__ size_t a_row0(const Gemm& g, int pm) { return g.amode == 0 ? (size_t)pm * 4 * g.ablk : (size_t)pm * 256 + 16 * (pm / 8 + 1); }

struct StaticOrder {
    int nM, nN, nwg, G, c;
    __host__ __device__ void init(int nM_, int nN_, int G_, int c_) { nM = nM_; nN = nN_; nwg = nM * nN; G = G_; c = c_; }
    __host__ __device__ bool next(int i, Unit& u) const {
        const long L = (long)i * G + c; if (L >= nwg) return false;
        int wgid = (int)L; { const int q = nwg / NXCD, r = nwg % NXCD, xcd = wgid % NXCD, off = wgid / NXCD; wgid = (xcd < r ? xcd * (q + 1) : r * (q + 1) + (xcd - r) * q) + off; }
        const int nig = WGM * nN, gid = wgid / nig, fm = gid * WGM, gsz = (nM - fm) < WGM ? (nM - fm) : WGM;
        u.pm = fm + ((wgid % nig) % gsz); u.pn = (wgid % nig) / gsz; return true;
    }
};

__device__ __forceinline__ unsigned cvt_pk_bf16(float lo, float hi) { unsigned r; asm volatile("v_cvt_pk_bf16_f32 %0, %1, %2" : "=v"(r) : "v"(lo), "v"(hi)); return r; }
__device__ __forceinline__ int lane_id_fresh() { int l; asm volatile("v_mbcnt_lo_u32_b32 %0, -1, 0\n\tv_mbcnt_hi_u32_b32 %0, -1, %0" : "=v"(l)); return l; }

template <class Epi, bool ALIGN_EPI>
__device__ __forceinline__ void gemm_phase(PG8_LAS unsigned char* lds, const Gemm g, const StaticOrder& S, const Epi& E, const int wave_id) {
    const int wid = wave_id, lane = lane_id_fresh(), tid = wid * 64 + lane, wr = wid >> 2, wc = wid & 3, fr = lane & 15, fq = lane >> 4;
    const int K = g.K, nt = K / BK;
    unsigned voffA[2], voffB[2];
#pragma unroll
    for (int i = 0; i < 2; ++i) { int R, C; stage_rc(tid * 16 + i * 8192, R, C); const int Rb = Epi::PERM ? ((R & ~31) + perm32(R & 31)) : R; const int Ra = (R >> 6) * g.ablk + (R & 63);
        voffA[i] = (unsigned)(Ra * K + C) * 2u; voffB[i] = (unsigned)(Rb * K + C) * 2u; }
    const size_t kstep = (size_t)(BK * 2);
    const size_t hstepB = (size_t)HALF * K * 2, tstepB = 2 * hstepB;
    const size_t hstepA = (size_t)2 * g.ablk * K * 2, rowB = (size_t)K * 2;
    const unsigned ldsw = (unsigned)wid * 1024u;
    const int aoff = lds_byte(wr * 64 + fr, fq * 8), boff = lds_byte(wc * 32 + fr, fq * 8);
#define PG8_SA(b, h) (((b) * 2 + (h)) * HTB)
#define PG8_SB(b, h) ((4 + (b) * 2 + (h)) * HTB)
#define PG8_STAGE(bufoff, gbase, voff) do { _Pragma("unroll") for (int _i = 0; _i < 2; ++_i) \
        __builtin_amdgcn_global_load_lds((const unsigned*)((const char*)(gbase) + (voff)[_i]), (PG8_LAS unsigned*)(lds + (bufoff) + ldsw + _i * 8192), 16, 0, 0); } while (0)
#define PG8_LDA(dst, b, h) do { _Pragma("unroll") for (int m = 0; m < 4; ++m) _Pragma("unroll") for (int k = 0; k < 2; ++k) dst[m][k] = *(const PG8_LAS bf16x8*)(lds + PG8_SA(b, h) + aoff + m * 2048 + k * 1024); } while (0)
#define PG8_LDB(dst, b, h) do { _Pragma("unroll") for (int n = 0; n < 2; ++n) _Pragma("unroll") for (int k = 0; k < 2; ++k) dst[n][k] = *(const PG8_LAS bf16x8*)(lds + PG8_SB(b, h) + boff + n * 2048 + k * 1024); } while (0)
#define PG8_MMA(ai, bj, At, Bt) do { __builtin_amdgcn_s_setprio(1); _Pragma("unroll") for (int m = 0; m < 4; ++m) _Pragma("unroll") for (int n = 0; n < 2; ++n) _Pragma("unroll") for (int k = 0; k < 2; ++k) \
        acc[ai][bj][m][n] = __builtin_amdgcn_mfma_f32_16x16x32_bf16(Bt[n][k], At[m][k], acc[ai][bj][m][n], 0, 0, 0); __builtin_amdgcn_s_setprio(0); } while (0)
#define PG8_WAIT_V(n) asm volatile("s_waitcnt vmcnt(" #n ")" ::: "memory")
#define PG8_WAIT_L(n) asm volatile("s_waitcnt lgkmcnt(" #n ")" ::: "memory")
#define PG8_BAR __builtin_amdgcn_s_barrier()
#define PG8_SCHED __builtin_amdgcn_sched_barrier(0)
    Unit cur, nxt; int ui = 0;
    if (!S.next(0, cur)) return;
    f32x4 acc[2][2][4][2];
#pragma unroll
    for (int a = 0; a < 2; ++a)
#pragma unroll
        for (int b = 0; b < 2; ++b)
#pragma unroll
            for (int m = 0; m < 4; ++m)
#pragma unroll
                for (int n = 0; n < 2; ++n) acc[a][b][m][n] = (f32x4){0.f, 0.f, 0.f, 0.f};
    bf16x8 At[4][2], B0[2][2], B1[2][2];
    const char* cA = (const char*)g.A + a_row0(g, cur.pm) * rowB; const char* cB = (const char*)g.Bt + (size_t)cur.pn * tstepB;
    PG8_STAGE(PG8_SB(0, 0), cB, voffB); PG8_STAGE(PG8_SB(0, 1), cB + hstepB, voffB); PG8_STAGE(PG8_SA(0, 0), cA, voffA); PG8_STAGE(PG8_SA(0, 1), cA + hstepA, voffA);
    if (wr == 1) PG8_BAR;
    PG8_WAIT_V(2); PG8_BAR;
    PG8_STAGE(PG8_SB(1, 0), cB + kstep, voffB); PG8_STAGE(PG8_SA(1, 0), cA + kstep, voffA); PG8_STAGE(PG8_SB(1, 1), cB + hstepB + kstep, voffB);
    PG8_WAIT_V(6); PG8_BAR;
    for (;;) {
        const bool has_next = S.next(ui + 1, nxt);
        const char* nA = has_next ? (const char*)g.A + a_row0(g, nxt.pm) * rowB : cA; const char* nB = has_next ? (const char*)g.Bt + (size_t)nxt.pn * tstepB : cB;
        for (int t = 0; t < nt; t += 2) {
            const bool last = (t == nt - 2);
            const char* a1 = cA + (size_t)(t + 1) * kstep;
            const char* a2 = last ? nA : cA + (size_t)(t + 2) * kstep; const char* b2 = last ? nB : cB + (size_t)(t + 2) * kstep;
            const char* a3 = a2 + kstep; const char* b3 = b2 + kstep;
            PG8_LDB(B0, 0, 0); PG8_LDB(B1, 0, 1); PG8_SCHED; PG8_LDA(At, 0, 0); PG8_STAGE(PG8_SA(1, 1), a1 + hstepA, voffA);
            PG8_WAIT_V(8); PG8_WAIT_L(0); PG8_BAR; PG8_MMA(0, 0, At, B0); PG8_MMA(0, 1, At, B1); PG8_BAR; PG8_SCHED;
            PG8_LDA(At, 0, 1); PG8_STAGE(PG8_SB(0, 0), b2, voffB); PG8_STAGE(PG8_SB(0, 1), b2 + hstepB, voffB); PG8_STAGE(PG8_SA(0, 0), a2, voffA);
            PG8_WAIT_V(8); PG8_WAIT_L(0); PG8_BAR; PG8_MMA(1, 0, At, B0); PG8_MMA(1, 1, At, B1); PG8_BAR; PG8_SCHED;
            PG8_LDB(B0, 1, 0); PG8_LDB(B1, 1, 1); PG8_SCHED; PG8_LDA(At, 1, 0); PG8_STAGE(PG8_SA(0, 1), a2 + hstepA, voffA);
            PG8_WAIT_V(8); PG8_WAIT_L(0); PG8_BAR; PG8_MMA(0, 0, At, B0); PG8_MMA(0, 1, At, B1); PG8_BAR; PG8_SCHED;
            PG8_LDA(At, 1, 1); PG8_STAGE(PG8_SB(1, 0), b3, voffB); PG8_STAGE(PG8_SB(1, 1), b3 + hstepB, voffB); PG8_STAGE(PG8_SA(1, 0), a3, voffA);
            PG8_WAIT_V(8); PG8_WAIT_L(0); PG8_BAR; PG8_MMA(1, 0, At, B0); PG8_MMA(1, 1, At, B1); PG8_BAR; PG8_SCHED;
        }
        if constexpr (ALIGN_EPI) { if (wr == 0) PG8_BAR; }
        E(acc, cur, wr, wc, fr, fq);
        if (!has_next) break;
#pragma unroll
        for (int a = 0; a < 2; ++a)
#pragma unroll
            for (int b = 0; b < 2; ++b)
#pragma unroll
                for (int m = 0; m < 4; ++m)
#pragma unroll
                    for (int n = 0; n < 2; ++n) acc[a][b][m][n] = (f32x4){0.f, 0.f, 0.f, 0.f};
        cur = nxt; cA = nA; cB = nB; ++ui;
        if constexpr (ALIGN_EPI) { if (wr == 1) PG8_BAR; }
    }
    PG8_WAIT_V(0);
    if constexpr (!ALIGN_EPI) { if (wr == 0) PG8_BAR; }
    PG8_BAR;
#undef PG8_SA
#undef PG8_SB
#undef PG8_STAGE
#undef PG8_LDA
#undef PG8_LDB
#undef PG8_MMA
#undef PG8_WAIT_V
#undef PG8_WAIT_L
#undef PG8_BAR
#undef PG8_SCHED
}
}

namespace {
using pg8::bf16_t; using pg8::bf16x8; using pg8::f32x4; using pg8::u32x4; using pg8::u32x2; using pg8::Unit; using pg8::cvt_pk_bf16;
#define LAS __attribute__((address_space(3)))
constexpr int NWAVES = 8;
constexpr int RING_BYTES = 131072, LDSCTL_OFF = RING_BYTES, MISC_OFF = LDSCTL_OFF + 320, LDS_BYTES = 147456;

__device__ __forceinline__ unsigned f2bf(float f) { unsigned u = __float_as_uint(f); return (u + 0x7fffu + ((u >> 16) & 1u)) >> 16; }
__device__ __forceinline__ float bf2f(unsigned b) { return __uint_as_float(b << 16); }
__device__ __forceinline__ unsigned pk2(float lo, float hi) { return f2bf(lo) | (f2bf(hi) << 16); }
__device__ __forceinline__ float wave_sum(float v) {
#pragma unroll
    for (int o = 1; o < 64; o <<= 1) v += __shfl_xor(v, o);
    return v;
}
__device__ __forceinline__ float hsum(f32x4 v) { return (v.x + v.y) + (v.z + v.w); }
__device__ __forceinline__ float hsq(f32x4 v) { return (v.x * v.x + v.y * v.y) + (v.z * v.z + v.w * v.w); }

__device__ __forceinline__ const float* xrow_ptr(const Params& p, int t) {
    if (t < TP) { const int b = t / PL, q = t - b * PL; return q < NMETA ? p.meta + (size_t)q * D : p.x_prompt + ((size_t)b * SEQ + (q - NMETA)) * D; }
    return p.x_sample + (size_t)(t - TP) * D;
}
__device__ __forceinline__ float* yrow_ptr(const Params& p, int t) {
    if (t < TP) { const int b = t / PL, q = t - b * PL; return q < NMETA ? nullptr : p.out + O_YP + ((size_t)b * SEQ + (q - NMETA)) * D; }
    if (t < T) return p.out + O_YS + (size_t)(t - TP) * D;
    return nullptr;
}

#define XB_TMO      128
#define XB_XCNT(j)  (256  + 64 * (j))
#define XB_XSUB(j)  (1280 + 64 * (j))
#define XB_XGEN(j)  (2304 + 64 * (j))
#define XB_TOP      3328
#define XB_TOPGEN   3392
#define XCD_BAR_WORDS 3456
#define XB_SPIN_CAP (1u << 18)
__device__ __forceinline__ unsigned xb_ld(unsigned* p)              { return __hip_atomic_load(p, __ATOMIC_RELAXED, __HIP_MEMORY_SCOPE_AGENT); }
__device__ __forceinline__ unsigned xb_add(unsigned* p, unsigned v) { return __hip_atomic_fetch_add(p, v, __ATOMIC_RELAXED, __HIP_MEMORY_SCOPE_AGENT); }
__device__ __forceinline__ unsigned xb_xcc_id() { return (unsigned)__builtin_amdgcn_s_getreg((3 << 11) | 20) & 0xFu; }
#define XB_SPIN(cond, bar) do { unsigned _sp = 0; while (cond) { __builtin_amdgcn_s_sleep(1); \
    if ((++_sp & 255u) == 0u) { if (xb_ld(&(bar)[XB_TMO])) break; if (_sp > XB_SPIN_CAP) { atomicAdd(&(bar)[XB_TMO], 1u); break; } } } } while (0)
struct XcdBarrier { unsigned* bar; unsigned x; volatile LAS unsigned* st; int wave; };
__device__ __forceinline__ bool xb_leader(int wave) { return wave == 0 && pg8::lane_id_fresh() == 0; }
__device__ __forceinline__ XcdBarrier xcd_barrier_post(unsigned* bar, volatile LAS unsigned* st, int wave) {
    XcdBarrier b; b.bar = bar; b.x = xb_xcc_id(); b.st = st; b.wave = wave;
    if (xb_leader(wave)) (void)xb_add(&bar[XB_XCNT(b.x)], 1u);
    return b;
}
__device__ __forceinline__ void xcd_barrier_complete(unsigned* bar, unsigned x, unsigned& nloc, unsigned& nx) {
    const unsigned G = gridDim.x * gridDim.y * gridDim.z;
    unsigned sum, cnt, mine, sp = 0u;
    for (;;) {
        sum = 0u; cnt = 0u; mine = 0u;
#pragma unroll
        for (unsigned j = 0; j < 16; ++j) { const unsigned c = xb_ld(&bar[XB_XCNT(j)]); sum += c; cnt += (c > 0u) ? 1u : 0u; mine = (j == x) ? c : mine; }
        if (sum == G) break;
        __builtin_amdgcn_s_sleep(1);
        if ((++sp & 255u) == 0u) { if (xb_ld(&bar[XB_TMO])) break; if (sp > XB_SPIN_CAP) { atomicAdd(&bar[XB_TMO], 1u); break; } }
    }
    nloc = mine > 0u ? mine : 1u; nx = cnt > 0u ? cnt : 1u;
}
__device__ __forceinline__ void xcd_barrier(const XcdBarrier& b) {
    asm volatile("s_waitcnt vmcnt(0)" ::: "memory");
    __syncthreads();
    if (xb_leader(b.wave)) {
        unsigned* bar = b.bar;
        __builtin_amdgcn_s_waitcnt(0);
        unsigned nloc = b.st[0], nx = b.st[1];
        if (nloc == 0u) { xcd_barrier_complete(bar, b.x, nloc, nx); b.st[0] = nloc; b.st[1] = nx; }
        const unsigned old = xb_add(&bar[XB_XSUB(b.x)], 1u);
        const unsigned gen = old / nloc;
        if (old + 1u == (gen + 1u) * nloc) {
            __builtin_amdgcn_fence(__ATOMIC_RELEASE, "agent");
            asm volatile("s_waitcnt vmcnt(0)" ::: "memory");
            const unsigned og = xb_add(&bar[XB_TOP], 1u);
            const unsigned tg = og / nx;
            if (og + 1u == (tg + 1u) * nx) xb_add(&bar[XB_TOPGEN], 1u);
            else XB_SPIN(xb_ld(&bar[XB_TOPGEN]) == tg, bar);
            __builtin_amdgcn_fence(__ATOMIC_ACQUIRE, "agent");
            xb_add(&bar[XB_XGEN(b.x)], 1u);
            asm volatile("s_waitcnt vmcnt(0)" ::: "memory");
        } else {
            XB_SPIN(xb_ld(&bar[XB_XGEN(b.x)]) == gen, bar);
            __builtin_amdgcn_fence(__ATOMIC_ACQUIRE, "agent");
            asm volatile("s_waitcnt vmcnt(0)" ::: "memory");
        }
    }
    __syncthreads();
}

struct EpiIn {
    static constexpr bool PERM = true;
    bf16_t* O; const float* r0;
    __device__ __forceinline__ void operator()(const f32x4 (&acc)[2][2][4][2], const Unit& u, int wr, int wc, int fr_, int fq_) const {
        const int lane_e = pg8::lane_id_fresh(), fr = lane_e & 15, fq = lane_e >> 4;
        const int row0 = u.pm * 256 + wr * 64 + fr, col0 = u.pn * 256 + wc * 32 + 8 * fq;
#pragma unroll
        for (int ai = 0; ai < 2; ++ai)
#pragma unroll
            for (int m = 0; m < 4; ++m) { const int row = row0 + ai * 128 + m * 16; const float sc = r0[row]; bf16_t* rowp = O + (size_t)row * NIN + col0;
#pragma unroll
                for (int bj = 0; bj < 2; ++bj) { const f32x4 v0 = acc[ai][bj][m][0] * sc, v1 = acc[ai][bj][m][1] * sc;
                    u32x4 w; w.x = cvt_pk_bf16(v0[0], v0[1]); w.y = cvt_pk_bf16(v0[2], v0[3]); w.z = cvt_pk_bf16(v1[0], v1[1]); w.w = cvt_pk_bf16(v1[2], v1[3]);
                    *(u32x4*)(rowp + bj * 128) = w; } }
    }
};
struct EpiOut {
    static constexpr bool PERM = true;
    Params p; bf16_t* x1b; float* ssq;
    __device__ __forceinline__ void operator()(const f32x4 (&acc)[2][2][4][2], const Unit& u, int wr, int wc, int fr_, int fq_) const {
        const int lane_e = pg8::lane_id_fresh(), fr = lane_e & 15, fq = lane_e >> 4;
        const int row0 = u.pm * 256 + wr * 64 + fr, col0 = u.pn * 256 + wc * 32 + 8 * fq;
#pragma unroll
        for (int am = 0; am < 4; ++am) { const int ai = am >> 1;
            f32x4 xv[2][2][2];
#pragma unroll
            for (int mm = 0; mm < 2; ++mm) { const int m = (am & 1) * 2 + mm; const int row = row0 + ai * 128 + m * 16; const float* xr = xrow_ptr(p, row < T ? row : 0);
#pragma unroll
                for (int bj = 0; bj < 2; ++bj) { xv[mm][bj][0] = *(const f32x4*)(xr + col0 + bj * 128); xv[mm][bj][1] = *(const f32x4*)(xr + col0 + bj * 128 + 4); } }
#pragma unroll
            for (int mm = 0; mm < 2; ++mm) { const int m = (am & 1) * 2 + mm; const int row = row0 + ai * 128 + m * 16; const float keep = row < T ? 1.f : 0.f; float* yr = yrow_ptr(p, row); float ss = 0.f;
#pragma unroll
                for (int bj = 0; bj < 2; ++bj) { const int col = col0 + bj * 128; const f32x4 a0 = acc[ai][bj][m][0] + xv[mm][bj][0] * keep, a1 = acc[ai][bj][m][1] + xv[mm][bj][1] * keep;
                    if (yr) { *(f32x4*)(yr + col) = a0; *(f32x4*)(yr + col + 4) = a1; }
                    u32x4 w; w.x = cvt_pk_bf16(a0[0], a0[1]); w.y = cvt_pk_bf16(a0[2], a0[3]); w.z = cvt_pk_bf16(a1[0], a1[1]); w.w = cvt_pk_bf16(a1[2], a1[3]);
                    *(u32x4*)(x1b + (size_t)row * D + col) = w; ss += hsq(a0) + hsq(a1); }
                ss += __shfl_xor(ss, 16); ss += __shfl_xor(ss, 32);
                if (fq == 0) atomicAdd(ssq + row, ss); }
        }
    }
};
struct EpiDown {
    static constexpr bool PERM = true;
    float* out; float* ssq;
    __device__ __forceinline__ void operator()(const f32x4 (&acc)[2][2][4][2], const Unit& u, int wr, int wc, int fr_, int fq_) const {
        const int lane_e = pg8::lane_id_fresh(), fr = lane_e & 15, fq = lane_e >> 4;
        const int row0 = u.pm * 256 + wr * 64 + fr, col0 = u.pn * 256 + wc * 32 + 8 * fq;
#pragma unroll
        for (int am = 0; am < 4; ++am) { const int ai = am >> 1;
            f32x4 xv[2][2][2];
#pragma unroll
            for (int mm = 0; mm < 2; ++mm) { const int m = (am & 1) * 2 + mm; const int row = row0 + ai * 128 + m * 16; const float* ld = out + (size_t)row * D;
#pragma unroll
                for (int bj = 0; bj < 2; ++bj) { xv[mm][bj][0] = *(const f32x4*)(ld + col0 + bj * 128); xv[mm][bj][1] = *(const f32x4*)(ld + col0 + bj * 128 + 4); } }
#pragma unroll
            for (int mm = 0; mm < 2; ++mm) { const int m = (am & 1) * 2 + mm; const int row = row0 + ai * 128 + m * 16; float* yr = out + (size_t)row * D; float ss = 0.f;
#pragma unroll
                for (int bj = 0; bj < 2; ++bj) { const int col = col0 + bj * 128; const f32x4 a0 = acc[ai][bj][m][0] + xv[mm][bj][0], a1 = acc[ai][bj][m][1] + xv[mm][bj][1];
                    *(f32x4*)(yr + col) = a0; *(f32x4*)(yr + col + 4) = a1; ss += hsq(a0) + hsq(a1); }
                ss += __shfl_xor(ss, 16); ss += __shfl_xor(ss, 32);
                if (fq == 0) ssq[(size_t)row * 16 + u.pn * 4 + wc] = ss; }
        }
    }
};
__device__ __forceinline__ void p5_sample(const Params& p, LAS unsigned char* lds, int w, int wave) {
    if (w >= 256) return;
    const int lane = pg8::lane_id_fresh(), fr = lane & 15, fq = lane >> 4, tr = w >> 4, tc = w & 15;
    const bf16_t* A = (const bf16_t*)(p.ws + WS_ACT) + (size_t)(TP + 32 * tr + fr) * DFF + wave * 352 + 8 * fq;
    const bf16_t* B = (const bf16_t*)(p.ws + WS_WDOWN) + (size_t)(64 * tc + fr) * DFF + wave * 352 + 8 * fq;
    f32x4 acc[2][4];
#pragma unroll
    for (int i = 0; i < 2; ++i)
#pragma unroll
        for (int j = 0; j < 4; ++j) acc[i][j] = (f32x4){0.f, 0.f, 0.f, 0.f};
#pragma unroll
    for (int kb = 0; kb < 3; ++kb) {
        bf16x8 a[4][2], b[4][4];
#pragma unroll
        for (int ks = 0; ks < 4; ++ks) if (4 * kb + ks < 11) { const int k = 32 * (4 * kb + ks);
#pragma unroll
            for (int i = 0; i < 2; ++i) a[ks][i] = *(const bf16x8*)(A + (size_t)(16 * i) * DFF + k);
#pragma unroll
            for (int j = 0; j < 4; ++j) b[ks][j] = *(const bf16x8*)(B + (size_t)(16 * j) * DFF + k); }
#pragma unroll
        for (int ks = 0; ks < 4; ++ks) if (4 * kb + ks < 11) {
#pragma unroll
            for (int i = 0; i < 2; ++i)
#pragma unroll
                for (int j = 0; j < 4; ++j) acc[i][j] = __builtin_amdgcn_mfma_f32_16x16x32_bf16(b[ks][j], a[ks][i], acc[i][j], 0, 0, 0); }
    }
    LAS float* P = (LAS float*)lds;
#pragma unroll
    for (int i = 0; i < 2; ++i)
#pragma unroll
        for (int j = 0; j < 4; ++j) *(LAS f32x4*)(P + (wave * 32 + 16 * i + fr) * 68 + 16 * j + 4 * fq) = acc[i][j];
    __syncthreads();
    const int tid = wave * 64 + lane, row = tid >> 4, c4 = tid & 15;
    f32x4 s = (f32x4){0.f, 0.f, 0.f, 0.f};
#pragma unroll
    for (int ww = 0; ww < 8; ++ww) s += *(const LAS f32x4*)(P + (ww * 32 + row) * 68 + 4 * c4);
    const int crow = NB * SEQ + 32 * tr + row;
    float* y = p.out + (size_t)crow * D + 64 * tc + 4 * c4;
    const f32x4 x2 = *(const f32x4*)y + s; *(f32x4*)y = x2;
    float ss = hsq(x2); ss += __shfl_xor(ss, 1); ss += __shfl_xor(ss, 2); ss += __shfl_xor(ss, 4); ss += __shfl_xor(ss, 8);
    if (c4 == 0) ((float*)(p.ws + WS_SSQ2))[(size_t)crow * 16 + tc] = ss;
    __syncthreads();
}
struct EpiUp {
    static constexpr bool PERM = true;
    const float* cw; const float* cb; float* ups; float* out; const float* ssq1; bf16_t* act;
    template <int CTRL> static __device__ __forceinline__ float dpp(float x) { return __builtin_bit_cast(float, __builtin_amdgcn_mov_dpp(__builtin_bit_cast(int, x), CTRL, 0xf, 0xf, true)); }
    typedef float f32x2 __attribute__((ext_vector_type(2)));
    static __device__ __forceinline__ f32x2 ld2(const float* p) { const float2 v = *(const float2*)p; return (f32x2){v.x, v.y}; }
    static __device__ __forceinline__ f32x2 bld2(__amdgpu_buffer_rsrc_t r, int voff, int soff) { return __builtin_bit_cast(f32x2, __builtin_amdgcn_raw_buffer_load_b64(r, voff, soff, 0)); }
    static __device__ __forceinline__ f32x2 fma2(f32x2 a, f32x2 b, f32x2 c) { return __builtin_elementwise_fma(a, b, c); }
    template <bool BND, bool SMPS>
    __device__ __forceinline__ void half(const f32x4 (&acc)[2][2][4][2], const int ai, const int tb, const int ch0, const int fr, __amdgpu_buffer_rsrc_t rw, __amdgpu_buffer_rsrc_t rb) const {
        float r1[4]; bool k1[4], k2[4]; int foff[4]; bool anyf = false;
        float q1[4];
#pragma unroll
        for (int m = 0; m < 4; ++m) { const int t = tb + 16 * m + fr; q1[m] = ssq1[t < 0 ? 0 : t]; }
#pragma unroll
        for (int m = 0; m < 4; ++m) { const int t = tb + 16 * m + fr; const float s = q1[m];
            r1[m] = t >= 0 ? rsqrtf(s * (1.f / D) + EPS) : 0.f;
            const bool valid = (m > 0 || fr >= 2) && t < T, isp = !SMPS || t < TP;
            const int b = t / PL, posp = t - b * PL;
            const bool want = valid && (isp ? posp >= PL - 2 : true);
            const int fo = isp ? (int)O_FP + (b * 2 + (posp - (PL - 2))) * NUP : (t - TP) * NUP;
            k1[m] = posp >= 1; k2[m] = posp >= 2; foff[m] = want ? fo : -1; anyf = anyf || want; }
        unsigned ov[4][4];
#pragma unroll
        for (int c4 = 0; c4 < 4; ++c4) { const int n = c4 >> 1, eh = c4 & 1, ch = ch0 + 2 * c4;
            const f32x2 w0v = bld2(rw, ch * 4, 0), w1v = bld2(rw, ch * 4, NUP * 4), w2v = bld2(rw, ch * 4, 2 * NUP * 4), bv = bld2(rb, ch * 4, 0);
            const f32x2 w0g = bld2(rw, ch * 4, DFF * 4), w1g = bld2(rw, ch * 4, (NUP + DFF) * 4), w2g = bld2(rw, ch * 4, (2 * NUP + DFF) * 4), bg = bld2(rb, ch * 4, DFF * 4);
            const f32x2 z2 = (f32x2){0.f, 0.f};
            f32x2 pr1v = z2, pr2v = z2, pr1g = z2, pr2g = z2;
#pragma unroll
            for (int m = 0; m < 4; ++m) {
                const f32x2 rr = (f32x2){r1[m], r1[m]};
                const f32x2 Vv = (f32x2){acc[ai][0][m][n][2 * eh], acc[ai][0][m][n][2 * eh + 1]} * rr, Vg = (f32x2){acc[ai][1][m][n][2 * eh], acc[ai][1][m][n][2 * eh + 1]} * rr;
                const f32x2 c1v = (f32x2){dpp<0x121>(Vv.x), dpp<0x121>(Vv.y)}, c2v = (f32x2){dpp<0x122>(Vv.x), dpp<0x122>(Vv.y)};
                const f32x2 c1g = (f32x2){dpp<0x121>(Vg.x), dpp<0x121>(Vg.y)}, c2g = (f32x2){dpp<0x122>(Vg.x), dpp<0x122>(Vg.y)};
                f32x2 p1v = fr >= 1 ? c1v : pr1v, p2v = fr >= 2 ? c2v : pr2v, p1g = fr >= 1 ? c1g : pr1g, p2g = fr >= 2 ? c2g : pr2g;
                pr1v = c1v; pr2v = c2v; pr1g = c1g; pr2g = c2g;
                if (BND) { p1v = k1[m] ? p1v : z2; p1g = k1[m] ? p1g : z2; p2v = k2[m] ? p2v : z2; p2g = k2[m] ? p2g : z2; }
                const f32x2 val = fma2(w0v, p2v, fma2(w1v, p1v, fma2(w2v, Vv, bv))), gate = fma2(w0g, p2g, fma2(w1g, p1g, fma2(w2g, Vg, bg)));
                const f32x2 ng = gate * (-1.4426950408889634f);
                f32x2 ex; ex.x = __builtin_amdgcn_exp2f(ng.x); ex.y = __builtin_amdgcn_exp2f(ng.y);
                const f32x2 den = ex + 1.0f;
                f32x2 rc; rc.x = __builtin_amdgcn_rcpf(den.x); rc.y = __builtin_amdgcn_rcpf(den.y);
                const f32x2 av = (val * gate) * rc;
                ov[m][c4] = cvt_pk_bf16(av.x, av.y);
            } }
#pragma unroll
        for (int m = 0; m < 4; ++m) { const int t = tb + 16 * m + fr; const bool valid = (m > 0 || fr >= 2) && (SMPS ? t < TP : t < T);
            if (valid) { u32x4 w; w.x = ov[m][0]; w.y = ov[m][1]; w.z = ov[m][2]; w.w = ov[m][3]; *(u32x4*)(act + (size_t)t * DFF + ch0) = w; } }
        if (__any(anyf)) {
#pragma unroll
            for (int m = 0; m < 4; ++m) if (foff[m] >= 0) { const int t = tb + 16 * m + fr;
                if (SMPS && t >= TP) { float* o = ups + foff[m] + ch0;
#pragma unroll
                    for (int n = 0; n < 2; ++n) { *(f32x4*)(o + 4 * n) = acc[ai][0][m][n] * r1[m]; *(f32x4*)(o + DFF + 4 * n) = acc[ai][1][m][n] * r1[m]; } }
                else { float* o = out + foff[m] + ch0;
#pragma unroll
                    for (int n = 0; n < 2; ++n) { *(f32x4*)(o + 4 * n) = acc[ai][0][m][n] * r1[m]; *(f32x4*)(o + DFF + 4 * n) = acc[ai][1][m][n] * r1[m]; } } }
        }
    }
    __device__ __forceinline__ void operator()(const f32x4 (&acc)[2][2][4][2], const Unit& u, int wr, int wc, int fr_, int fq_) const {
        const int lane_e = pg8::lane_id_fresh(), fr = lane_e & 15, fq = lane_e >> 4;
        const int ch0 = u.pn * 128 + wc * 32 + 8 * fq;
        const __amdgpu_buffer_rsrc_t rw = __builtin_amdgcn_make_buffer_rsrc((void*)cw, 0, 3 * NUP * 4, 0x00020000), rb = __builtin_amdgcn_make_buffer_rsrc((void*)cb, 0, NUP * 4, 0x00020000);
#pragma unroll
        for (int ai = 0; ai < 2; ++ai) {
            const int tb = ETILE * u.pm - 2 + EBLK * (2 * ai + wr);
            if (tb + 63 >= TP) half<true, true>(acc, ai, tb, ch0, fr, rw, rb);
            else { const int lo = tb < 0 ? 0 : tb, nxt = ((lo + PL - 1) / PL) * PL;
                   const bool bnd = (nxt <= tb + 63) || (lo - (lo / PL) * PL) < 2;
                   if (bnd) half<true, false>(acc, ai, tb, ch0, fr, rw, rb); else half<false, false>(acc, ai, tb, ch0, fr, rw, rb); }
        }
    }
};
__device__ __forceinline__ void p4b_phase(const Params& p, int gw, int NGW) {
    const int lane = pg8::lane_id_fresh();
    const float* ups = (const float*)(p.ws + WS_UPS); bf16_t* act = (bf16_t*)(p.ws + WS_ACT);
    for (int it = gw; it < TS * (DFF / 256); it += NGW) {
        const int row = it / (DFF / 256), ch = (it - row * (DFF / 256)) * 256 + 4 * lane, sq = row >> 2, j = row & 3;
        const float* c0 = ups + (size_t)row * NUP + ch; const float* c1 = ups + (size_t)(j >= 1 ? row - 1 : row) * NUP + ch; const float* c2 = ups + (size_t)(j >= 2 ? row - 2 : row) * NUP + ch;
        const float* s1 = p.state_ffn + ((size_t)sq * 2 + 1) * NUP + ch; const float* s2 = p.state_ffn + ((size_t)sq * 2 + (j & 1)) * NUP + ch;
        const f32x4 uv = *(const f32x4*)c0, ug = *(const f32x4*)(c0 + DFF), a1v = *(const f32x4*)c1, a1g = *(const f32x4*)(c1 + DFF), a2v = *(const f32x4*)c2, a2g = *(const f32x4*)(c2 + DFF);
        const f32x4 t1v = *(const f32x4*)s1, t1g = *(const f32x4*)(s1 + DFF), t2v = *(const f32x4*)s2, t2g = *(const f32x4*)(s2 + DFF);
        const float* cw = p.ffn_conv_w + ch; const float* cb = p.ffn_conv_b + ch;
        const f32x4 w0v = *(const f32x4*)cw, w1v = *(const f32x4*)(cw + NUP), w2v = *(const f32x4*)(cw + 2 * NUP), bv = *(const f32x4*)cb;
        const f32x4 w0g = *(const f32x4*)(cw + DFF), w1g = *(const f32x4*)(cw + NUP + DFF), w2g = *(const f32x4*)(cw + 2 * NUP + DFF), bg = *(const f32x4*)(cb + DFF);
        const f32x4 p1v = j >= 1 ? a1v : t1v, p1g = j >= 1 ? a1g : t1g, p2v = j >= 2 ? a2v : t2v, p2g = j >= 2 ? a2g : t2g;
        const f32x4 val = w0v * p2v + w1v * p1v + w2v * uv + bv, gate = w0g * p2g + w1g * p1g + w2g * ug + bg;
        f32x4 a;
#pragma unroll
        for (int e = 0; e < 4; ++e) a[e] = val[e] * gate[e] * __builtin_amdgcn_rcpf(1.f + __builtin_amdgcn_exp2f(gate[e] * -1.4426950408889634f));
        u32x2 o; o.x = cvt_pk_bf16(a[0], a[1]); o.y = cvt_pk_bf16(a[2], a[3]); *(u32x2*)(act + (size_t)(TP + row) * DFF + ch) = o;
        if (j >= DS - 2) { float* d = p.out + O_FS + ((size_t)sq * 2 + (j - (DS - 2))) * NUP + ch; *(f32x4*)d = uv; *(f32x4*)(d + DFF) = ug; }
    }
}

__device__ __forceinline__ int wup_src_col(int n) { const int pn = n >> 8, w = n & 255, bj = w >> 7, c = w & 127; return bj * DFF + 128 * pn + c; }
template <bool MAP>
__device__ __forceinline__ void p0_transpose_item(const float* W, int K, int N, int NP, bf16_t* WT, const float* gain, LAS float* scr, int item, int lane) {
    const int nblk = NP / 32, kb = item / nblk, nb = item % nblk, k0 = 64 * kb, n0 = 32 * nb, s0 = MAP ? wup_src_col(n0) : n0;
    float v[32];
#pragma unroll
    for (int i = 0; i < 32; ++i) { const int kk = 2 * i + (lane >> 5); v[i] = W[(size_t)(k0 + kk) * N + s0 + (lane & 31)]; }
    const int c = lane & 7;
    f32x4 g0 = (f32x4){1.f, 1.f, 1.f, 1.f}, g1 = g0;
    if (gain) { g0 = *(const f32x4*)(gain + k0 + 8 * c); g1 = *(const f32x4*)(gain + k0 + 8 * c + 4); }
#pragma unroll
    for (int i = 0; i < 32; ++i) { const int kk = 2 * i + (lane >> 5); scr[kk * 33 + (lane & 31)] = v[i]; }
    asm volatile("s_waitcnt lgkmcnt(0)" ::: "memory");
#pragma unroll
    for (int j = 0; j < 4; ++j) { const int n = (lane >> 3) + 8 * j; const LAS float* s = scr + (8 * c) * 33 + n;
        u32x4 o; o.x = pk2(s[0 * 33] * g0.x, s[1 * 33] * g0.y); o.y = pk2(s[2 * 33] * g0.z, s[3 * 33] * g0.w); o.z = pk2(s[4 * 33] * g1.x, s[5 * 33] * g1.y); o.w = pk2(s[6 * 33] * g1.z, s[7 * 33] * g1.w);
        *(u32x4*)(WT + (size_t)(n0 + n) * K + k0 + 8 * c) = o; }
    asm volatile("s_waitcnt lgkmcnt(0)" ::: "memory");
}
__device__ __forceinline__ void p0_prologue(const Params& p, LAS unsigned char* lds, int gw, int NGW, int wave) {
    const int lane = pg8::lane_id_fresh();
    LAS float* scr = (LAS float*)(lds + wave * 16384);
    bf16_t* win = (bf16_t*)(p.ws + WS_WIN); bf16_t* wout = (bf16_t*)(p.ws + WS_WOUT); bf16_t* wup = (bf16_t*)(p.ws + WS_WUP); bf16_t* wdown = (bf16_t*)(p.ws + WS_WDOWN); bf16_t* wpool = (bf16_t*)(p.ws + WS_WPOOL);
    constexpr int I_IN = (D / 64) * (NIN / 32), I_OUT = (D / 64) * (D / 32), I_UP = (D / 64) * (NUP / 32), I_DN = (DFF / 64) * (D / 32), I_PL = 4 * (128 / 64) * (128 / 32);
    constexpr int NITEMS = I_IN + I_OUT + I_UP + I_DN + I_PL;
    bf16_t* xb = (bf16_t*)(p.ws + WS_XB); float* r0 = (float*)(p.ws + WS_R0); bf16_t* mix = (bf16_t*)(p.ws + WS_MIX); bf16_t* x1b = (bf16_t*)(p.ws + WS_X1B);
    for (int tq = gw; tq < T / 4; tq += NGW) {
        f32x4 v[4][4];
#pragma unroll
        for (int r = 0; r < 4; ++r) { const f32x4* xr = (const f32x4*)xrow_ptr(p, 4 * tq + r) + lane;
#pragma unroll
            for (int j = 0; j < 4; ++j) v[r][j] = xr[64 * j]; }
#pragma unroll
        for (int r = 0; r < 4; ++r) { const int t = 4 * tq + r; float s = 0.f;
#pragma unroll
            for (int j = 0; j < 4; ++j) s += hsq(v[r][j]);
            s = wave_sum(s);
            if (lane == 0) r0[t] = rsqrtf(s * (1.f / D) + EPS);
            unsigned long long* o8 = (unsigned long long*)(xb + (size_t)t * D) + lane;
#pragma unroll
            for (int j = 0; j < 4; ++j) o8[64 * j] = (unsigned long long)pk2(v[r][j].x, v[r][j].y) | ((unsigned long long)pk2(v[r][j].z, v[r][j].w) << 32); }
    }
    { float* ssq1 = (float*)(p.ws + WS_SSQ1); for (int t = gw * 64 + lane; t < MPAD; t += NGW * 64) ssq1[t] = 0.f; }
    for (int t = T + gw; t < MPAD + X1B_PADROWS; t += NGW) {
        if (t >= MPAD) { unsigned long long* o8 = (unsigned long long*)(x1b + (size_t)(t - MPAD) * D) + lane; for (int j = 0; j < 4; ++j) o8[64 * j] = 0ull; continue; }
        unsigned long long* o8 = (unsigned long long*)(xb + (size_t)t * D) + lane; unsigned long long* m8 = (unsigned long long*)(mix + (size_t)t * D) + lane;
        for (int j = 0; j < 4; ++j) { o8[64 * j] = 0ull; m8[64 * j] = 0ull; } if (lane == 0) r0[t] = 0.f;
    }
    for (int it = gw; it < NITEMS; it += NGW) {
        int r = it;
        if (r < I_IN) { p0_transpose_item<false>(p.w_in, D, NIN, NIN, win, p.norm_mix, scr, r, lane); continue; } r -= I_IN;
        if (r < I_UP) { p0_transpose_item<true>(p.w_up, D, NUP, NUP, wup, p.norm_ffn, scr, r, lane); continue; } r -= I_UP;
        if (r < I_DN) { p0_transpose_item<false>(p.w_down, DFF, D, D, wdown, nullptr, scr, r, lane); continue; } r -= I_DN;
        if (r < I_OUT) { p0_transpose_item<false>(p.w_out, D, D, D, wout, nullptr, scr, r, lane); continue; } r -= I_OUT;
        { const int g = r >> 3; p0_transpose_item<false>(p.w_pool + (size_t)g * 16384, 128, 128, 128, wpool + (size_t)g * 16384, nullptr, scr, r & 7, lane); }
    }
}

constexpr int MIX_ROWB = 272;
template <int W>
__device__ __forceinline__ void pool_prompt_tile(const Params& p, const bf16_t* proj, LAS unsigned char* scr, int t0, int b, int p0, int g, int lane) {
    const int cu = 128 * g + 2 * lane;
    unsigned uw[31];
#pragma unroll
    for (int dr = 0; dr < 31; ++dr) { const int tr = t0 - 15 + dr; uw[dr] = *(const unsigned*)(proj + (size_t)(tr < 0 ? 0 : tr) * NIN + cu); }
    float ua[31], ub[31];
#pragma unroll
    for (int dr = 0; dr < 31; ++dr) { const unsigned w = (p0 - 15 + dr >= 0) ? uw[dr] : 0u; ua[dr] = bf2f(w & 0xffffu); ub[dr] = bf2f(w >> 16); }
    float ca[32], cb2[32]; ca[0] = 0.f; cb2[0] = 0.f;
#pragma unroll
    for (int dr = 0; dr < 31; ++dr) { ca[dr + 1] = ca[dr] + ua[dr]; cb2[dr + 1] = cb2[dr] + ub[dr]; }
#pragma unroll
    for (int i = 0; i < 16; ++i) {
        const int pos = p0 + i; const float inv = 1.f / (float)(pos + 1 < W ? pos + 1 : W);
        const float da = (ca[16 + i] - ca[16 + i - W]) * inv - ua[15 + i], db = (cb2[16 + i] - cb2[16 + i - W]) * inv - ub[15 + i];
        *(LAS unsigned*)(scr + i * MIX_ROWB + 4 * lane) = pk2(da, db);
        if (pos >= PL - PBUF) { float2 o; o.x = ua[15 + i]; o.y = ub[15 + i]; *(float2*)(p.out + O_PP + ((size_t)b * PBUF + (pos - (PL - PBUF))) * POOLW + cu) = o; }
    }
}
template <int W>
__device__ __forceinline__ void pool_sample_tile(const Params& p, const bf16_t* proj, LAS unsigned char* scr, int t0, int s0, int g, int lane) {
    const int cu = 128 * g + 2 * lane;
#pragma unroll
    for (int q = 0; q < 4; ++q) { const int sq = s0 + q;
        float2 ex[19];
#pragma unroll
        for (int r = 0; r < 15; ++r) ex[r] = *(const float2*)(p.state_pool + ((size_t)sq * PBUF + r) * POOLW + cu);
#pragma unroll
        for (int j = 0; j < 4; ++j) { const unsigned w = *(const unsigned*)(proj + (size_t)(t0 + 4 * q + j) * NIN + cu); ex[15 + j].x = bf2f(w & 0xffffu); ex[15 + j].y = bf2f(w >> 16); }
        float ca[20], cb2[20]; ca[0] = 0.f; cb2[0] = 0.f;
#pragma unroll
        for (int r = 0; r < 19; ++r) { ca[r + 1] = ca[r] + ex[r].x; cb2[r + 1] = cb2[r] + ex[r].y; }
#pragma unroll
        for (int j = 0; j < 4; ++j) { const float inv = 1.f / (float)W;
            const float da = (ca[16 + j] - ca[16 + j - W]) * inv - ex[15 + j].x, db = (cb2[16 + j] - cb2[16 + j - W]) * inv - ex[15 + j].y;
            *(LAS unsigned*)(scr + (4 * q + j) * MIX_ROWB + 4 * lane) = pk2(da, db); }
#pragma unroll
        for (int r = 0; r < PBUF; ++r) *(float2*)(p.out + O_PS + ((size_t)sq * PBUF + r) * POOLW + cu) = ex[r + DS];
    }
}
__device__ __forceinline__ void mixer_phase(const Params& p, LAS unsigned char* lds, int gw, int NGW, int wave) {
    const int lane = pg8::lane_id_fresh();
    LAS unsigned char* scr = lds + wave * 8192;
    const bf16_t* proj = (const bf16_t*)(p.ws + WS_PROJ); bf16_t* mix = (bf16_t*)(p.ws + WS_MIX); const bf16_t* wpool = (const bf16_t*)(p.ws + WS_WPOOL);
    const int fr = lane & 15, fq = lane >> 4;
    constexpr int NITEM = (T / 16) * 4;
    for (int it = gw; it < NITEM; it += NGW) {
        const int tt = it >> 2, qd = it & 3, t0 = 16 * tt, g = qd, cc = 128 * qd + 2 * lane;
        const float2 w0 = *(const float2*)(p.conv_w + cc), w1 = *(const float2*)(p.conv_w + CONVW + cc), w2 = *(const float2*)(p.conv_w + 2 * CONVW + cc);
        if (t0 < TP) {
            const int b = t0 / PL, p0 = t0 - b * PL;
            unsigned zc[18], zv[18], zg[16];
#pragma unroll
            for (int dr = 0; dr < 18; ++dr) { const int tr = t0 - 2 + dr; const bf16_t* row = proj + (size_t)(tr < 0 ? 0 : tr) * NIN; zc[dr] = *(const unsigned*)(row + 1024 + cc); zv[dr] = *(const unsigned*)(row + 1536 + cc); }
#pragma unroll
            for (int i = 0; i < 16; ++i) zg[i] = *(const unsigned*)(proj + (size_t)(t0 + i) * NIN + 512 + cc);
            if (g == 0) pool_prompt_tile<2>(p, proj, scr, t0, b, p0, g, lane);
            else if (g == 1) pool_prompt_tile<4>(p, proj, scr, t0, b, p0, g, lane);
            else if (g == 2) pool_prompt_tile<8>(p, proj, scr, t0, b, p0, g, lane);
            else pool_prompt_tile<16>(p, proj, scr, t0, b, p0, g, lane);
            float za[18], zb[18];
#pragma unroll
            for (int dr = 0; dr < 18; ++dr) { const bool ok = p0 - 2 + dr >= 0; const unsigned wc_ = ok ? zc[dr] : 0u, wv = zv[dr];
                za[dr] = bf2f(wc_ & 0xffffu) * bf2f(wv & 0xffffu); zb[dr] = bf2f(wc_ >> 16) * bf2f(wv >> 16); }
#pragma unroll
            for (int i = 0; i < 16; ++i) { const unsigned wg = zg[i];
                const float ca_ = w0.x * za[i] + w1.x * za[i + 1] + w2.x * za[i + 2], cb_ = w0.y * zb[i] + w1.y * zb[i + 1] + w2.y * zb[i + 2];
                *(unsigned*)(mix + (size_t)(t0 + i) * D + 512 + cc) = pk2(bf2f(wg & 0xffffu) * ca_, bf2f(wg >> 16) * cb_);
                const int pos = p0 + i; if (pos >= PL - 2) { float2 o; o.x = za[i + 2]; o.y = zb[i + 2]; *(float2*)(p.out + O_CP + ((size_t)b * 2 + (pos - (PL - 2))) * CONVW + cc) = o; } }
        } else {
            const int s0 = (t0 - TP) >> 2;
            if (g == 0) pool_sample_tile<2>(p, proj, scr, t0, s0, g, lane);
            else if (g == 1) pool_sample_tile<4>(p, proj, scr, t0, s0, g, lane);
            else if (g == 2) pool_sample_tile<8>(p, proj, scr, t0, s0, g, lane);
            else pool_sample_tile<16>(p, proj, scr, t0, s0, g, lane);
#pragma unroll
            for (int q = 0; q < 4; ++q) { const int sq = s0 + q;
                float za[6], zb[6]; unsigned zg[4];
#pragma unroll
                for (int r = 0; r < 2; ++r) { const float2 s = *(const float2*)(p.state_conv + ((size_t)sq * 2 + r) * CONVW + cc); za[r] = s.x; zb[r] = s.y; }
#pragma unroll
                for (int j = 0; j < 4; ++j) { const bf16_t* row = proj + (size_t)(t0 + 4 * q + j) * NIN; const unsigned wc_ = *(const unsigned*)(row + 1024 + cc), wv = *(const unsigned*)(row + 1536 + cc);
                    za[2 + j] = bf2f(wc_ & 0xffffu) * bf2f(wv & 0xffffu); zb[2 + j] = bf2f(wc_ >> 16) * bf2f(wv >> 16); zg[j] = *(const unsigned*)(row + 512 + cc); }
#pragma unroll
                for (int j = 0; j < 4; ++j) { const float ca_ = w0.x * za[j] + w1.x * za[j + 1] + w2.x * za[j + 2], cb_ = w0.y * zb[j] + w1.y * zb[j + 1] + w2.y * zb[j + 2];
                    *(unsigned*)(mix + (size_t)(t0 + 4 * q + j) * D + 512 + cc) = pk2(bf2f(zg[j] & 0xffffu) * ca_, bf2f(zg[j] >> 16) * cb_);
                    if (j >= DS - 2) { float2 o; o.x = za[2 + j]; o.y = zb[2 + j]; *(float2*)(p.out + O_CS + ((size_t)sq * 2 + (j - (DS - 2))) * CONVW + cc) = o; } }
            }
        }
        asm volatile("s_waitcnt lgkmcnt(0)" ::: "memory");
        bf16x8 af[4];
#pragma unroll
        for (int s = 0; s < 4; ++s) af[s] = *(const LAS bf16x8*)(scr + fr * MIX_ROWB + (32 * s + 8 * fq) * 2);
#pragma unroll
        for (int nh = 0; nh < 2; ++nh) {
            bf16x8 bfr[4][4]; f32x4 sc[4];
#pragma unroll
            for (int nb = 0; nb < 4; ++nb) { sc[nb] = *(const f32x4*)(p.pool_scale + 128 * g + 16 * (4 * nh + nb) + 4 * fq);
#pragma unroll
                for (int s = 0; s < 4; ++s) bfr[nb][s] = *(const bf16x8*)(wpool + ((size_t)(g * 128 + 16 * (4 * nh + nb) + fr)) * 128 + 32 * s + 8 * fq); }
#pragma unroll
            for (int nb = 0; nb < 4; ++nb) { f32x4 a = (f32x4){0.f, 0.f, 0.f, 0.f};
#pragma unroll
                for (int s = 0; s < 4; ++s) a = __builtin_amdgcn_mfma_f32_16x16x32_bf16(bfr[nb][s], af[s], a, 0, 0, 0);
                const int col = 128 * g + 16 * (4 * nh + nb) + 4 * fq; a = a * sc[nb];
                u32x2 o; o.x = cvt_pk_bf16(a[0], a[1]); o.y = cvt_pk_bf16(a[2], a[3]); *(u32x2*)(mix + (size_t)(t0 + fr) * D + col) = o; } }
        asm volatile("s_waitcnt lgkmcnt(0)" ::: "memory");
    }
}

__device__ __forceinline__ void final_phase(const Params& p, int gw, int NGW) {
    const int lane = pg8::lane_id_fresh();
    const float* ssq2 = (const float*)(p.ws + WS_SSQ2);
    f32x4 gv[4];
#pragma unroll
    for (int j = 0; j < 4; ++j) gv[j] = *((const f32x4*)p.norm_final + lane + 64 * j);
    constexpr int NROW = NB * SEQ + TS;
    for (int tq = gw; tq < NROW / 4; tq += NGW) {
        f32x4 v[4][4], q4[4][4];
#pragma unroll
        for (int r = 0; r < 4; ++r) { const f32x4* yr = (const f32x4*)(p.out + (size_t)(4 * tq + r) * D) + lane; const f32x4* q = (const f32x4*)(ssq2 + (size_t)(4 * tq + r) * 16);
#pragma unroll
            for (int j = 0; j < 4; ++j) { v[r][j] = yr[64 * j]; q4[r][j] = q[j]; } }
#pragma unroll
        for (int r = 0; r < 4; ++r) { const float s = (hsum(q4[r][0]) + hsum(q4[r][1])) + (hsum(q4[r][2]) + hsum(q4[r][3])); const float rr = rsqrtf(s * (1.f / D) + EPS);
            f32x4* yr = (f32x4*)(p.out + (size_t)(4 * tq + r) * D) + lane;
#pragma unroll
            for (int j = 0; j < 4; ++j) yr[64 * j] = v[r][j] * rr * gv[j]; }
    }
}

struct Args { Params p; int mask; int bar_region; };
__global__ void __launch_bounds__(NWAVES * 64, 2) fwd_megakernel(Args args) {
    extern __shared__ __attribute__((aligned(16))) unsigned char lds_raw[];
    LAS unsigned char* lds = (LAS unsigned char*)lds_raw;
    const Params& p = args.p;
    const int wave = __builtin_amdgcn_readfirstlane((int)threadIdx.x >> 6), tid = wave * 64 + pg8::lane_id_fresh();
    const int G = gridDim.x, bx = blockIdx.x, vcu = (G % 8 == 0) ? (bx % 8) * (G / 8) + bx / 8 : bx;
    const int gw = vcu * NWAVES + wave, NGW = G * NWAVES;
    unsigned* ctl = (unsigned*)(p.ws + WS_CTL);
    for (int u = tid; u < (LDS_BYTES - LDSCTL_OFF) / 4; u += NWAVES * 64) ((LAS unsigned*)(lds + LDSCTL_OFF))[u] = 0u;
    __syncthreads();
    const XcdBarrier bar = xcd_barrier_post(ctl + CW_BAR + args.bar_region * XCD_BAR_WORDS, (volatile LAS unsigned*)(lds + MISC_OFF) + 8, wave);

    const int mask = args.mask;
    if (mask & 1) { p0_prologue(p, lds, gw, NGW, wave); xcd_barrier(bar); }
    if (mask & 2) { pg8::Gemm g{(const bf16_t*)(p.ws + WS_XB), (const bf16_t*)(p.ws + WS_WIN), D, 64, 0}; pg8::StaticOrder S; S.init(NM, NIN / 256, G, bx);
      EpiIn E{(bf16_t*)(p.ws + WS_PROJ), (const float*)(p.ws + WS_R0)};
      pg8::gemm_phase<EpiIn, true>(lds, g, S, E, wave); xcd_barrier(bar); }
    if (mask & 4) { mixer_phase(p, lds, gw, NGW, wave); xcd_barrier(bar); }
    if (mask & 8) { pg8::Gemm g{(const bf16_t*)(p.ws + WS_MIX), (const bf16_t*)(p.ws + WS_WOUT), D, 64, 0}; pg8::StaticOrder S; S.init(NM, D / 256, G, bx);
      EpiOut E{p, (bf16_t*)(p.ws + WS_X1B) + (size_t)X1B_PADROWS * D, (float*)(p.ws + WS_SSQ1)};
      pg8::gemm_phase<EpiOut, true>(lds, g, S, E, wave); xcd_barrier(bar); }
    if (mask & 16) { pg8::Gemm g{(const bf16_t*)(p.ws + WS_X1B) + (size_t)(X1B_PADROWS - 2) * D, (const bf16_t*)(p.ws + WS_WUP), D, EBLK, 0}; pg8::StaticOrder S; S.init(NME, NUP / 256, G, bx);
      EpiUp E{p.ffn_conv_w, p.ffn_conv_b, (float*)(p.ws + WS_UPS), p.out, (const float*)(p.ws + WS_SSQ1), (bf16_t*)(p.ws + WS_ACT)};
      pg8::gemm_phase<EpiUp, true>(lds, g, S, E, wave); xcd_barrier(bar); p4b_phase(p, gw, NGW); xcd_barrier(bar); }
    if (mask & 32) { pg8::Gemm g{(const bf16_t*)(p.ws + WS_ACT), (const bf16_t*)(p.ws + WS_WDOWN), DFF, 64, 1}; pg8::StaticOrder S; S.init(NB * SEQ / 256, D / 256, G, bx);
      EpiDown E{p.out, (float*)(p.ws + WS_SSQ2)};
      pg8::gemm_phase<EpiDown, true>(lds, g, S, E, wave);
      p5_sample(p, lds, vcu, wave); xcd_barrier(bar); }
    if (mask & 64) final_phase(p, gw, NGW);
}
}

extern "C" void kernel_launch(void* const* d_in, const int* in_sizes, int n_in, void* d_out, int out_size, void* d_ws, size_t ws_size, hipStream_t stream) {
    static int grid = 0;
    if (grid == 0) {
        if (n_in != 18 || ws_size < WS_END) { fprintf(stderr, "kernel_launch: unexpected inputs (n_in %d, ws %zu)\n", n_in, ws_size); grid = -1; return; }
        int dev = 0, cus = 0, per_cu = 0;
        if (hipGetDevice(&dev) != hipSuccess || hipDeviceGetAttribute(&cus, hipDeviceAttributeMultiprocessorCount, dev) != hipSuccess) { grid = -1; return; }
        if (hipFuncSetAttribute((const void*)fwd_megakernel, hipFuncAttributeMaxDynamicSharedMemorySize, LDS_BYTES) != hipSuccess) { fprintf(stderr, "kernel_launch: hipFuncSetAttribute failed\n"); grid = -1; return; }
        if (hipOccupancyMaxActiveBlocksPerMultiprocessor(&per_cu, (const void*)fwd_megakernel, NWAVES * 64, LDS_BYTES) != hipSuccess || per_cu < 1)
            fprintf(stderr, "kernel_launch: note: occupancy query reports %d workgroups per CU\n", per_cu);
        (void)hipGetLastError();
        grid = cus;
    }
    if (grid < 0) return;
    (void)hipMemsetAsync((char*)d_ws + WS_CTL, 0, CTL_ZERO_BYTES, stream);
    Args a{};
    Params& p = a.p;
    p.x_prompt = (const float*)d_in[0]; p.x_sample = (const float*)d_in[1]; p.state_pool = (const float*)d_in[2]; p.state_conv = (const float*)d_in[3]; p.state_ffn = (const float*)d_in[4];
    p.meta = (const float*)d_in[5]; p.norm_mix = (const float*)d_in[6]; p.w_in = (const float*)d_in[7]; p.w_pool = (const float*)d_in[8]; p.pool_scale = (const float*)d_in[9];
    p.conv_w = (const float*)d_in[10]; p.w_out = (const float*)d_in[11]; p.norm_ffn = (const float*)d_in[12]; p.w_up = (const float*)d_in[13]; p.ffn_conv_w = (const float*)d_in[14];
    p.ffn_conv_b = (const float*)d_in[15]; p.w_down = (const float*)d_in[16]; p.norm_final = (const float*)d_in[17];
    p.out = (float*)d_out; p.ws = (unsigned char*)d_ws;
    a.mask = 127; a.bar_region = 0;
    hipLaunchKernelGGL(fwd_megakernel, dim3(grid), dim3(NWAVES * 64), LDS_BYTES, stream, a);
#ifdef PROBE_MASK
    a.mask = PROBE_MASK; a.bar_region = 1;
    hipLaunchKernelGGL(fwd_megakernel, dim3(grid), dim3(NWAVES * 64), LDS_BYTES, stream, a);
#endif
    const hipError_t le = hipPeekAtLastError();
    if (le != hipSuccess) fprintf(stderr, "kernel_launch: launch failed: %s\n", hipGetErrorName(le));
}
```
